# Optimizing an MI355X kernel written in HIP

```python
import math
import jax, jax.numpy as jnp
from jax import lax
import numpy as np

D_MODEL = 1024
BATCH = 32
SEQ = 2048
DEPTH = 1

N_META = 16
SSM_WIDTH = 1024
SSM_GROUP = 16
SSM_GROUPS = SSM_WIDTH // SSM_GROUP
SSM_STATE = 64
DT_MIN = 1e-3
DT_MAX = 1e-1
HGRN_WIDTH = 1024
HGRN_HEAD_DIM = 128
HGRN_HEADS = HGRN_WIDTH // HGRN_HEAD_DIM
HGRN_CHUNK = 16
D_FF = 2816
CONV_WIDTH = 3
EPS = 1e-6
IN_COLS = SSM_WIDTH + 4 * HGRN_WIDTH + 2 * D_MODEL

kernel_name = 'hybrid_s5_hgrn2_gated_merge_block'


def rmsnorm(x, g):
    xf = x.astype(jnp.float32)
    y = xf * lax.rsqrt(jnp.mean(xf * xf, axis=-1, keepdims=True) + EPS)
    return (y * g.astype(jnp.float32)).astype(x.dtype)


def _complex_affine_combine(e1, e2):
    a1r, a1i, b1r, b1i = e1
    a2r, a2i, b2r, b2i = e2
    ar = a1r * a2r - a1i * a2i
    ai = a1r * a2i + a1i * a2r
    br = a2r * b1r - a2i * b1i + b2r
    bi = a2r * b1i + a2i * b1r + b2i
    return ar, ai, br, bi


def s5_mixer(u, lam_re, lam_im, log_dt, b_re, b_im, c_re, c_im, d_skip, w_glu):
    bsz, L, _ = u.shape
    uf = u.astype(jnp.float32).reshape(bsz, L, SSM_GROUPS, SSM_GROUP)
    lr = lam_re.astype(jnp.float32)
    li = lam_im.astype(jnp.float32)
    dt = jnp.exp(log_dt.astype(jnp.float32))[:, None]
    mag = jnp.exp(lr * dt)
    ab_re = mag * jnp.cos(li * dt)
    ab_im = mag * jnp.sin(li * dt)
    den = lr * lr + li * li
    nr = ab_re - 1.0
    coef_re = (nr * lr + ab_im * li) / den
    coef_im = (ab_im * lr - nr * li) / den
    br = b_re.astype(jnp.float32)
    bi = b_im.astype(jnp.float32)
    bb_re = coef_re[..., None] * br - coef_im[..., None] * bi
    bb_im = coef_re[..., None] * bi + coef_im[..., None] * br
    v_re = jnp.einsum('blgh,gph->blgp', uf, bb_re)
    v_im = jnp.einsum('blgh,gph->blgp', uf, bb_im)
    a_re = jnp.broadcast_to(ab_re[None, None], (1, L, SSM_GROUPS, SSM_STATE))
    a_im = jnp.broadcast_to(ab_im[None, None], (1, L, SSM_GROUPS, SSM_STATE))
    _, _, s_re, s_im = lax.associative_scan(_complex_affine_combine, (a_re, a_im, v_re, v_im), axis=1)
    y = (jnp.einsum('blgp,ghp->blgh', s_re, c_re.astype(jnp.float32))
         - jnp.einsum('blgp,ghp->blgh', s_im, c_im.astype(jnp.float32))
         + d_skip.astype(jnp.float32).reshape(SSM_GROUPS, SSM_GROUP) * uf)
    y = jax.nn.gelu(y.reshape(bsz, L, SSM_WIDTH)).astype(u.dtype)
    return y * jax.nn.sigmoid(y @ w_glu)


def hgrn2_mixer(q, f_logit, i_in, og, lb, norm_g):
    bsz, L, _ = q.shape
    n_chunks = L // HGRN_CHUNK

    def heads(t):
        return t.reshape(bsz, n_chunks, HGRN_CHUNK, HGRN_HEADS, HGRN_HEAD_DIM).transpose(1, 0, 3, 2, 4)

    lbf = lb.astype(jnp.float32)
    f = lbf + (1.0 - lbf) * jax.nn.sigmoid(f_logit.astype(jnp.float32))
    log_f = jnp.log(f)
    qh = heads(q.astype(jnp.float32))
    kh = heads(1.0 - f)
    vh = heads(i_in.astype(jnp.float32))
    cum = jnp.cumsum(heads(log_f), axis=3)
    q_in = qh * jnp.exp(cum)
    k_in = kh * jnp.exp(-cum)
    k_out = kh * jnp.exp(cum[..., -1:, :] - cum)
    chunk_decay = jnp.exp(cum[..., -1, :])
    causal = jnp.tril(jnp.ones((HGRN_CHUNK, HGRN_CHUNK), dtype=bool))

    def chunk_step(state, xs):
        qi, ki, ko, v, dec = xs
        scores = jnp.where(causal, jnp.einsum('bhtd,bhsd->bhts', qi, ki), 0.0)
        o = jnp.einsum('bhts,bhsv->bhtv', scores, v) + jnp.einsum('bhtd,bhdv->bhtv', qi, state)
        state = dec[..., None] * state + jnp.einsum('bhsd,bhsv->bhdv', ko, v)
        return state, o

    init = jnp.zeros((bsz, HGRN_HEADS, HGRN_HEAD_DIM, HGRN_HEAD_DIM), jnp.float32)
    _, o = lax.scan(chunk_step, init, (q_in, k_in, k_out, vh, chunk_decay))
    o = o.transpose(1, 0, 3, 2, 4).reshape(bsz, L, HGRN_HEADS, HGRN_HEAD_DIM)
    o = o * lax.rsqrt(jnp.mean(o * o, axis=-1, keepdims=True) + EPS) * norm_g.astype(jnp.float32)
    o = o.reshape(bsz, L, HGRN_WIDTH).astype(q.dtype)
    return o * jax.nn.silu(og)


def causal_dwconv(u, w, b):
    L = u.shape[1]
    up = jnp.pad(u, ((0, 0), (CONV_WIDTH - 1, 0), (0, 0)))
    out = b
    for j in range(CONV_WIDTH):
        out = out + up[:, j:j + L, :] * w[j]
    return out


def setup_inputs(seed: int = 0) -> dict:
    key = jax.random.key(seed)
    ks = jax.random.split(key, 24)
    f32 = jnp.float32

    def nrm(k, shape, scale):
        return jax.random.normal(k, shape, f32) * scale

    n_idx = jnp.arange(SSM_STATE, dtype=f32)
    return {
        'x': nrm(ks[0], (BATCH, SEQ, D_MODEL), 1.0),
        'meta_tokens': nrm(ks[1], (N_META, D_MODEL), 1.0),
        'mix_norm_g': 1.0 + nrm(ks[2], (DEPTH, D_MODEL), 0.02),
        'w_in': nrm(ks[3], (DEPTH, D_MODEL, IN_COLS), D_MODEL ** -0.5),
        'ssm_lambda_re': -0.5 + nrm(ks[4], (DEPTH, SSM_GROUPS, SSM_STATE), 0.01),
        'ssm_lambda_im': math.pi * n_idx + nrm(ks[5], (DEPTH, SSM_GROUPS, SSM_STATE), 0.01),
        'ssm_log_dt': jax.random.uniform(ks[6], (DEPTH, SSM_GROUPS), f32, math.log(DT_MIN), math.log(DT_MAX)),
        'ssm_b_re': nrm(ks[7], (DEPTH, SSM_GROUPS, SSM_STATE, SSM_GROUP), (2 * SSM_GROUP) ** -0.5),
        'ssm_b_im': nrm(ks[8], (DEPTH, SSM_GROUPS, SSM_STATE, SSM_GROUP), (2 * SSM_GROUP) ** -0.5),
        'ssm_c_re': nrm(ks[9], (DEPTH, SSM_GROUPS, SSM_GROUP, SSM_STATE), SSM_STATE ** -0.5),
        'ssm_c_im': nrm(ks[10], (DEPTH, SSM_GROUPS, SSM_GROUP, SSM_STATE), SSM_STATE ** -0.5),
        'ssm_d': nrm(ks[11], (DEPTH, SSM_WIDTH), 1.0),
        'ssm_w_glu': nrm(ks[12], (DEPTH, SSM_WIDTH, SSM_WIDTH), SSM_WIDTH ** -0.5),
        'w_ssm_proj': nrm(ks[13], (DEPTH, SSM_WIDTH, D_MODEL), SSM_WIDTH ** -0.5),
        'hgrn_lb_logits': nrm(ks[14], (DEPTH + 1, HGRN_WIDTH), 0.1),
        'hgrn_norm_g': 1.0 + nrm(ks[15], (DEPTH, HGRN_HEAD_DIM), 0.02),
        'w_hgrn_proj': nrm(ks[16], (DEPTH, HGRN_WIDTH, D_MODEL), HGRN_WIDTH ** -0.5),
        'w_out': nrm(ks[17], (DEPTH, D_MODEL, D_MODEL), D_MODEL ** -0.5),
        'ffn_norm_g': 1.0 + nrm(ks[18], (DEPTH, D_MODEL), 0.02),
        'w_up': nrm(ks[19], (DEPTH, D_MODEL, 2 * D_FF), D_MODEL ** -0.5),
        'conv_w': nrm(ks[20], (DEPTH, CONV_WIDTH, 2 * D_FF), CONV_WIDTH ** -0.5),
        'conv_b': nrm(ks[21], (DEPTH, 2 * D_FF), 0.01),
        'w_down': nrm(ks[22], (DEPTH, D_FF, D_MODEL), D_FF ** -0.5),
        'final_norm_g': 1.0 + nrm(ks[23], (D_MODEL,), 0.02),
    }


def reference(x, meta_tokens, mix_norm_g, w_in, ssm_lambda_re, ssm_lambda_im, ssm_log_dt,
              ssm_b_re, ssm_b_im, ssm_c_re, ssm_c_im, ssm_d, ssm_w_glu, w_ssm_proj,
              hgrn_lb_logits, hgrn_norm_g, w_hgrn_proj, w_out, ffn_norm_g, w_up, conv_w,
              conv_b, w_down, final_norm_g):
    bsz = x.shape[0]
    meta = jnp.broadcast_to(meta_tokens.astype(x.dtype)[None], (bsz, N_META, D_MODEL))
    h = jnp.concatenate([meta, x], axis=1)
    lower_bounds = jnp.cumsum(jax.nn.softmax(hgrn_lb_logits.astype(jnp.float32), axis=0), axis=0)
    o1 = SSM_WIDTH
    o2 = o1 + HGRN_WIDTH
    o3 = o2 + HGRN_WIDTH
    o4 = o3 + HGRN_WIDTH
    o5 = o4 + HGRN_WIDTH
    o6 = o5 + D_MODEL
    for l in range(DEPTH):
        z = rmsnorm(h, mix_norm_g[l])
        p = z @ w_in[l]
        y_a = s5_mixer(p[..., :o1], ssm_lambda_re[l], ssm_lambda_im[l], ssm_log_dt[l],
                       ssm_b_re[l], ssm_b_im[l], ssm_c_re[l], ssm_c_im[l], ssm_d[l], ssm_w_glu[l])
        y_b = hgrn2_mixer(p[..., o1:o2], p[..., o2:o3], p[..., o3:o4], p[..., o4:o5],
                          lower_bounds[l], hgrn_norm_g[l])
        merged = (jax.nn.sigmoid(p[..., o5:o6]) * (y_a @ w_ssm_proj[l])
                  + jax.nn.sigmoid(p[..., o6:]) * (y_b @ w_hgrn_proj[l]))
        h = h + merged @ w_out[l]
        z = rmsnorm(h, ffn_norm_g[l])
        u = causal_dwconv(z @ w_up[l], conv_w[l], conv_b[l])
        h = h + (jax.nn.silu(u[..., :D_FF]) * u[..., D_FF:]) @ w_down[l]
    return rmsnorm(h[:, N_META:], final_norm_g)
```

```cpp
#include <hip/hip_runtime.h>
#include <hip/hip_cooperative_groups.h>
#include <cstdio>
#include <cstdint>
namespace cg = cooperative_groups;

#ifndef MK_PER_PHASE
#define MK_PER_PHASE 0
#endif

#define LAS __attribute__((address_space(3)))
typedef unsigned short bf16_t;
typedef short bf16x8 __attribute__((ext_vector_type(8)));
typedef short bf16x4 __attribute__((ext_vector_type(4)));
typedef float f32x4 __attribute__((ext_vector_type(4)));
typedef float f32x2 __attribute__((ext_vector_type(2)));
typedef unsigned u32x4 __attribute__((ext_vector_type(4)));
typedef unsigned u32x2 __attribute__((ext_vector_type(2)));

constexpr int D = 1024, BATCH = 32, SEQ = 2048, NMETA = 16, LTOK = SEQ + NMETA, M = BATCH * LTOK;
constexpr int CPB = LTOK / 16, NCH = M / 16;
constexpr int DFF = 2816, NUP = 2 * DFF;
constexpr int NIN = 7168, NG1A = 5120, NG1B = 2048;
constexpr int S5_MT = 16;
constexpr int XS_LD = 384;
constexpr float EPS = 1e-6f;
constexpr int UP_MT = 261, UP_STRIDE = 254;

constexpr size_t UB = (size_t)M * 1024 * 2;
constexpr size_t W_WIN = 0;
constexpr size_t W_GLU = W_WIN + (size_t)NIN * 1024 * 2;
constexpr size_t W_A = W_GLU + 2097152, W_B = W_A + 2097152, W_O = W_B + 2097152;
constexpr size_t W_UP = W_O + 2097152;
constexpr size_t W_DN = W_UP + (size_t)NUP * 1024 * 2;
constexpr size_t W_KE = W_DN + (size_t)1024 * DFF * 2;
constexpr size_t W_W5 = W_KE + (size_t)64 * 256 * 384 * 2;
constexpr size_t W_END = W_W5 + (size_t)64 * 256 * 256 * 2;
constexpr size_t SLOT0 = 64u << 20;
constexpr size_t CTL_OFF = SLOT0 - 4096;
static_assert(W_END <= CTL_OFF, "weights region");
#define SLOT(i) (SLOT0 + (size_t)(i) * UB)
constexpr size_t SM0 = SLOT0 + 7 * UB;
constexpr size_t SM_RS1 = SM0;
constexpr size_t SM_SSQ2 = SM_RS1 + (size_t)M * 4;
constexpr size_t SM_SSQ3 = SM_SSQ2 + (size_t)M * 64;
constexpr size_t SM_DEC = SM_SSQ3 + (size_t)M * 64;
constexpr size_t SM_A16 = SM_DEC + (size_t)NCH * 4096;
constexpr size_t WS_NEED = SM_A16 + 64 * 64 * 8;

__device__ __forceinline__ unsigned cvt_pk_bf16(float lo, float hi) { unsigned r; asm volatile("s_nop 1\n\tv_cvt_pk_bf16_f32 %0, %1, %2" : "=v"(r) : "v"(lo), "v"(hi)); return r; }
__device__ __forceinline__ float bf_lo(unsigned w) { return __uint_as_float(w << 16); }
__device__ __forceinline__ float bf_hi(unsigned w) { return __uint_as_float(w & 0xffff0000u); }
__device__ __forceinline__ float sigm(float x) { return __builtin_amdgcn_rcpf(1.f + __expf(-x)); }
__device__ __forceinline__ float gelu_tanh(float x) { const float z = 1.5957691216f * (x + 0.044715f * x * x * x); return x * sigm(z); }
__device__ __forceinline__ int lane_id_v() { int l; asm volatile("v_mbcnt_lo_u32_b32 %0, -1, 0\n\tv_mbcnt_hi_u32_b32 %0, -1, %0" : "=v"(l)); return l; }
template <int CTRL> __device__ __forceinline__ float dpp_f1(float x) { return __int_as_float(__builtin_amdgcn_update_dpp(0x3f800000, __float_as_int(x), CTRL, 0xF, 0xF, false)); }
template <int CTRL> __device__ __forceinline__ float dpp_fo(float old, float x) { return __int_as_float(__builtin_amdgcn_update_dpp(__float_as_int(old), __float_as_int(x), CTRL, 0xF, 0xF, false)); }
__device__ __forceinline__ float xsum_rows(float x) {
    const u32x2 a = __builtin_amdgcn_permlane16_swap(__float_as_uint(x), __float_as_uint(x), false, false);
    x = __uint_as_float(a[0]) + __uint_as_float(a[1]);
    const u32x2 b = __builtin_amdgcn_permlane32_swap(__float_as_uint(x), __float_as_uint(x), false, false);
    return __uint_as_float(b[0]) + __uint_as_float(b[1]);
}
template <int CTRL> __device__ __forceinline__ float dpp_f(float x) { return __int_as_float(__builtin_amdgcn_update_dpp(0, __float_as_int(x), CTRL, 0xF, 0xF, true)); }
__device__ __forceinline__ float wave_sum(float v) {
#pragma unroll
    for (int o = 1; o < 64; o <<= 1) v += __shfl_xor(v, o);
    return v;
}
__device__ __forceinline__ void unpack8(const u32x4 w, float (&v)[8]) {
    v[0] = bf_lo(w.x); v[1] = bf_hi(w.x); v[2] = bf_lo(w.y); v[3] = bf_hi(w.y); v[4] = bf_lo(w.z); v[5] = bf_hi(w.z); v[6] = bf_lo(w.w); v[7] = bf_hi(w.w);
}
__device__ __forceinline__ u32x4 pack8(const f32x4 a, const f32x4 b) {
    u32x4 w; w.x = cvt_pk_bf16(a[0], a[1]); w.y = cvt_pk_bf16(a[2], a[3]); w.z = cvt_pk_bf16(b[0], b[1]); w.w = cvt_pk_bf16(b[2], b[3]); return w;
}

namespace pg8 {
constexpr int BM = 256, BK = 64, HALF = 128, HTB = HALF * BK * 2, STAGE_BYTES = 8 * HTB, NXCD = 8, WGM = 8;
__host__ __device__ __forceinline__ int lds_byte(int r, int c) { const int st = (r >> 4) * 2 + (c >> 5), rr = r & 15, cc = c & 31, ob = rr * 64 + cc * 2; return st * 1024 + (ob ^ (((ob >> 9) & 1) << 5)); }
__host__ __device__ __forceinline__ void stage_rc(int b, int& R, int& C) { const int st = b / 1024, sb = b % 1024, swz = sb ^ (((sb >> 9) & 1) << 5); R = (st >> 1) * 16 + swz / 64; C = (st & 1) * 32 + (swz % 64) / 2; }
__host__ __device__ __forceinline__ int perm32(int rho) { const int n = rho >> 4, i = rho & 15; return 8 * (i >> 2) + 4 * n + (i & 3); }

struct Unit { int pm, pn; long offA, offB; };
struct Gemm { const bf16_t* A; const bf16_t* Bt; int K, lda, ldb; int a_hrows = 128; };

struct TileOrder {
    int nM, nN, nwg, G, c, a_stride, a_row0, lda, ldb, split_pn; long a2_off, b2_off;
    __device__ void init(int nM_, int nN_, int G_, int c_, int lda_, int ldb_, int a_stride_ = 256, int a_row0_ = 0) { nM = nM_; nN = nN_; nwg = nM * nN; G = G_; c = c_; lda = lda_; ldb = ldb_; a_stride = a_stride_; a_row0 = a_row0_; split_pn = 1 << 30; a2_off = 0; b2_off = 0; }
    __device__ bool next(int i, Unit& u) const {
        const long L = (long)i * G + c; if (L >= nwg) return false;
        int wgid = (int)L; { const int q = nwg / NXCD, r = nwg % NXCD, xcd = wgid % NXCD, off = wgid / NXCD; wgid = (xcd < r ? xcd * (q + 1) : r * (q + 1) + (xcd - r) * q) + off; }
        const int nig = WGM * nN, gid = wgid / nig, fm = gid * WGM, gsz = (nM - fm) < WGM ? (nM - fm) : WGM;
        u.pm = fm + ((wgid % nig) % gsz); u.pn = (wgid % nig) / gsz;
        u.offA = ((long)u.pm * a_stride + a_row0) * lda * 2; u.offB = (long)u.pn * 256 * ldb * 2;
        if (u.pn >= split_pn) { u.offA += a2_off; u.offB = b2_off + (long)(u.pn - split_pn) * 256 * ldb * 2; }
        return true;
    }
};
struct GroupOrder {
    int G, c, ldb, row0;
    __device__ void init(int G_, int c_, int ldb_, int row0_) { G = G_; c = c_; ldb = ldb_; row0 = row0_; }
    __device__ bool next(int i, Unit& u) const {
        const unsigned L = (unsigned)(i * G + c); if (L >= 64u * S5_MT) return false;
        const unsigned q = L >> 5, j = (L >> 3) & 3u, x = L & 7u, sg = q * 8u + x, g4 = sg / (unsigned)S5_MT;
        u.pn = (int)(4u * g4 + j); u.pm = (int)(sg - g4 * (unsigned)S5_MT);
        u.offA = ((long)u.pn * NCH + (long)u.pm * 2 * CPB + row0) * XS_LD * 2; u.offB = (long)u.pn * 256 * ldb * 2; return true;
    }
};

template <class Epi, class Sched>
__device__ __forceinline__ void gemm_phase(LAS unsigned char* lds, const Gemm g, const Sched& S, const Epi& E, const int wv) {
    const int tid = wv * 64 + lane_id_v();
    const int wid = __builtin_amdgcn_readfirstlane(tid >> 6), lane = tid & 63, wr = wid >> 2, wc = wid & 3, fr = lane & 15, fq = lane >> 4;
    const int K = g.K, nt = K / BK;
    unsigned voffA[2], voffB[2];
#pragma unroll
    for (int i = 0; i < 2; ++i) { int R, C; stage_rc(tid * 16 + i * 8192, R, C); const int Rb = (R & ~31) + perm32(R & 31);
        voffA[i] = (unsigned)(R * g.lda + C) * 2u; voffB[i] = (unsigned)(Rb * g.ldb + C) * 2u; }
    const size_t kstep = (size_t)(BK * 2);
    const size_t hstepA = (size_t)g.a_hrows * g.lda * 2, hstepB = (size_t)HALF * g.ldb * 2;
    const unsigned ldsw = (unsigned)wid * 1024u;
    const int aoff = lds_byte(wr * 64 + fr, fq * 8), boff = lds_byte(wc * 32 + fr, fq * 8);
#define PG8_SA(b, h) (((b) * 2 + (h)) * HTB)
#define PG8_SB(b, h) ((4 + (b) * 2 + (h)) * HTB)
#define PG8_STAGE(bufoff, gbase, voff) do { _Pragma("unroll") for (int _i = 0; _i < 2; ++_i) \
        __builtin_amdgcn_global_load_lds((const unsigned*)((const char*)(gbase) + (voff)[_i]), (LAS unsigned*)(lds + (bufoff) + ldsw + _i * 8192), 16, 0, 0); } while (0)
#define PG8_LDA(dst, b, h) do { _Pragma("unroll") for (int m = 0; m < 4; ++m) _Pragma("unroll") for (int k = 0; k < 2; ++k) dst[m][k] = *(const LAS bf16x8*)(lds + PG8_SA(b, h) + aoff + m * 2048 + k * 1024); } while (0)
#define PG8_LDB(dst, b, h) do { _Pragma("unroll") for (int n = 0; n < 2; ++n) _Pragma("unroll") for (int k = 0; k < 2; ++k) dst[n][k] = *(const LAS bf16x8*)(lds + PG8_SB(b, h) + boff + n * 2048 + k * 1024); } while (0)
#define PG8_MMA(ai, bj, At, Bt) do { __builtin_amdgcn_s_setprio(1); _Pragma("unroll") for (int m = 0; m < 4; ++m) _Pragma("unroll") for (int n = 0; n < 2; ++n) _Pragma("unroll") for (int k = 0; k < 2; ++k) \
        acc[ai][bj][m][n] = __builtin_amdgcn_mfma_f32_16x16x32_bf16(Bt[n][k], At[m][k], acc[ai][bj][m][n], 0, 0, 0); __builtin_amdgcn_s_setprio(0); } while (0)
#define PG8_WAIT_V(n) asm volatile("s_waitcnt vmcnt(" #n ")" ::: "memory")
#define PG8_WAIT_L(n) asm volatile("s_waitcnt lgkmcnt(" #n ")" ::: "memory")
#define PG8_BAR __builtin_amdgcn_s_barrier()
#define PG8_SCHED __builtin_amdgcn_sched_barrier(0)
    Unit cur, nxt; int ui = 0;
    if (!S.next(0, cur)) return;
    f32x4 acc[2][2][4][2];
#pragma unroll
    for (int a = 0; a < 2; ++a)
#pragma unroll
        for (int b = 0; b < 2; ++b)
#pragma unroll
            for (int m = 0; m < 4; ++m)
#pragma unroll
                for (int n = 0; n < 2; ++n) acc[a][b][m][n] = (f32x4){0.f, 0.f, 0.f, 0.f};
    bf16x8 At[4][2], B0[2][2], B1[2][2];
    const char* cA = (const char*)g.A + cur.offA; const char* cB = (const char*)g.Bt + cur.offB;
    PG8_STAGE(PG8_SB(0, 0), cB, voffB); PG8_STAGE(PG8_SB(0, 1), cB + hstepB, voffB); PG8_STAGE(PG8_SA(0, 0), cA, voffA); PG8_STAGE(PG8_SA(0, 1), cA + hstepA, voffA);
    if (wr == 1) PG8_BAR;
    PG8_WAIT_V(2); PG8_BAR;
    PG8_STAGE(PG8_SB(1, 0), cB + kstep, voffB); PG8_STAGE(PG8_SA(1, 0), cA + kstep, voffA); PG8_STAGE(PG8_SB(1, 1), cB + hstepB + kstep, voffB);
    PG8_WAIT_V(6); PG8_BAR;
    for (;;) {
        const bool has_next = S.next(ui + 1, nxt);
        const char* nA = has_next ? (const char*)g.A + nxt.offA : cA; const char* nB = has_next ? (const char*)g.Bt + nxt.offB : cB;
#pragma unroll 1
        for (int t = 0; t < nt; t += 2) {
            const bool last = (t == nt - 2);
            const char* a1 = cA + (size_t)(t + 1) * kstep;
            const char* a2 = last ? nA : cA + (size_t)(t + 2) * kstep; const char* b2 = last ? nB : cB + (size_t)(t + 2) * kstep;
            const char* a3 = a2 + kstep; const char* b3 = b2 + kstep;
            PG8_LDB(B0, 0, 0); PG8_LDB(B1, 0, 1); PG8_SCHED; PG8_LDA(At, 0, 0); PG8_STAGE(PG8_SA(1, 1), a1 + hstepA, voffA);
            PG8_WAIT_V(8); PG8_WAIT_L(0); PG8_BAR; PG8_MMA(0, 0, At, B0); PG8_MMA(0, 1, At, B1); PG8_BAR; PG8_SCHED;
            PG8_LDA(At, 0, 1); PG8_STAGE(PG8_SB(0, 0), b2, voffB); PG8_STAGE(PG8_SB(0, 1), b2 + hstepB, voffB); PG8_STAGE(PG8_SA(0, 0), a2, voffA);
            PG8_WAIT_V(8); PG8_WAIT_L(0); PG8_BAR; PG8_MMA(1, 0, At, B0); PG8_MMA(1, 1, At, B1); PG8_BAR; PG8_SCHED;
            PG8_LDB(B0, 1, 0); PG8_LDB(B1, 1, 1); PG8_SCHED; PG8_LDA(At, 1, 0); PG8_STAGE(PG8_SA(0, 1), a2 + hstepA, voffA);
            PG8_WAIT_V(8); PG8_WAIT_L(0); PG8_BAR; PG8_MMA(0, 0, At, B0); PG8_MMA(0, 1, At, B1); PG8_BAR; PG8_SCHED;
            PG8_LDA(At, 1, 1); PG8_STAGE(PG8_SB(1, 0), b3, voffB); PG8_STAGE(PG8_SB(1, 1), b3 + hstepB, voffB); PG8_STAGE(PG8_SA(1, 0), a3, voffA);
            PG8_WAIT_V(8); PG8_WAIT_L(0); PG8_BAR; PG8_MMA(1, 0, At, B0); PG8_MMA(1, 1, At, B1); PG8_BAR; PG8_SCHED;
        }
        if (wr == 0) PG8_BAR;
        { const int l2 = lane_id_v(); E(acc, cur, wr, wc, l2 & 15, (l2 >> 4) & 3); }
        if (!has_next) break;
#pragma unroll
        for (int a = 0; a < 2; ++a)
#pragma unroll
            for (int b = 0; b < 2; ++b)
#pragma unroll
                for (int m = 0; m < 4; ++m)
#pragma unroll
                    for (int n = 0; n < 2; ++n) acc[a][b][m][n] = (f32x4){0.f, 0.f, 0.f, 0.f};
        cur = nxt; cA = nA; cB = nB; ++ui;
        if (wr == 1) PG8_BAR;
    }
    PG8_WAIT_V(0);
    PG8_BAR;
#undef PG8_SA
#undef PG8_SB
#undef PG8_STAGE
#undef PG8_LDA
#undef PG8_LDB
#undef PG8_MMA
#undef PG8_WAIT_V
#undef PG8_WAIT_L
#undef PG8_BAR
#undef PG8_SCHED
}
}
using pg8::Unit;
typedef f32x4 Acc[2][2][4][2];

#define FOR_AI_M _Pragma("unroll") for (int ai = 0; ai < 2; ++ai) _Pragma("unroll") for (int m = 0; m < 4; ++m)
#define FOR_BJ _Pragma("unroll") for (int bj = 0; bj < 2; ++bj)

struct EpiG1a {
    bf16_t* xs5; bf16_t* qi; bf16_t* ki; bf16_t* vb; bf16_t* ogb; float* dec; const float* rs1; const float* lbl;
    __device__ __forceinline__ void operator()(Acc& acc, const Unit& u, int wr, int wc, int fr, int fq) const {
        const int row0 = u.pm * 256 + wr * 64 + fr;
        float rsa[2][4];
        FOR_AI_M rsa[ai][m] = rs1[row0 + ai * 128 + m * 16];
        if (u.pn >= 4 && u.pn < 12) {
            const int hh = u.pn - 4, d0 = hh * 128 + wc * 32 + fq * 8;
            float lb[8];
#pragma unroll
            for (int i = 0; i < 8; ++i) lb[i] = sigm(lbl[d0 + i] - lbl[1024 + d0 + i]);
            FOR_AI_M {
                const int row = row0 + ai * 128 + m * 16; const float rs = rsa[ai][m];
                f32x4 oq[2], ok[2], od[2];
#pragma unroll
                for (int n = 0; n < 2; ++n)
#pragma unroll
                    for (int j = 0; j < 4; ++j) {
                        const float q = rs * acc[ai][0][m][n][j]; const float v = rs * acc[ai][1][m][n][j];
                        const float l = lb[n * 4 + j], e = __expf(-v), sg = __builtin_amdgcn_rcpf(1.f + e);
                        const float f = l + (1.f - l) * sg, kk = (1.f - l) * (1.f - sg);
                        float e1 = f;
                        e1 *= dpp_f1<0x111>(e1); e1 *= dpp_f1<0x112>(e1); e1 *= dpp_f1<0x114>(e1); e1 *= dpp_f1<0x118>(e1);
                        oq[n][j] = q * e1; ok[n][j] = kk * __builtin_amdgcn_rcpf(e1); od[n][j] = e1;
                    }
                *(u32x4*)(qi + (size_t)row * 1024 + d0) = pack8(oq[0], oq[1]);
                *(u32x4*)(ki + (size_t)row * 1024 + d0) = pack8(ok[0], ok[1]);
                if (fr == 15) { float* dp = dec + (size_t)(row >> 4) * 1024 + d0; *(f32x4*)dp = od[0]; *(f32x4*)(dp + 4) = od[1]; }
            }
        } else if (u.pn < 4) {
            FOR_AI_M {
                const int row = row0 + ai * 128 + m * 16; const float rs = rsa[ai][m];
                const int n_ch = row >> 4, t = row & 15;
                FOR_BJ {
                    const int g = u.pn * 16 + bj * 8 + wc * 2 + (fq >> 1), h0 = (fq & 1) * 8;
                    *(u32x4*)(xs5 + ((size_t)g * NCH + n_ch) * XS_LD + t * 16 + h0) = pack8(acc[ai][bj][m][0] * rs, acc[ai][bj][m][1] * rs);
                }
            }
        } else {
            bf16_t* dst = (u.pn < 16) ? vb : ogb; const int c0 = ((u.pn - 12) & 3) * 256 + wc * 32 + fq * 8;
            FOR_AI_M {
                const int row = row0 + ai * 128 + m * 16; const float rs = rsa[ai][m];
                FOR_BJ *(u32x4*)(dst + (size_t)row * 1024 + c0 + bj * 128) = pack8(acc[ai][bj][m][0] * rs, acc[ai][bj][m][1] * rs);
            }
        }
    }
};
struct EpiS5i {
    bf16_t* L;
    __device__ __forceinline__ void operator()(Acc& acc, const Unit& u, int wr, int wc, int fr, int fq) const {
        FOR_AI_M {
            const int ch = (2 * u.pm + ai) * CPB + wr * 64 + m * 16 + fr;
            *(u32x4*)(L + ((size_t)u.pn * NCH + ch) * 128 + wc * 32 + fq * 8) = pack8(acc[ai][0][m][0], acc[ai][0][m][1]);
        }
    }
};
struct EpiS5y {
    const bf16_t* xs5; const float* dsk; bf16_t* y;
    __device__ __forceinline__ void operator()(Acc& acc, const Unit& u, int wr, int wc, int fr, int fq) const {
        const int g = u.pn, h0 = (fq & 1) * 8;
        const f32x4 dva = *(const f32x4*)(dsk + g * 16 + h0), dvb = *(const f32x4*)(dsk + g * 16 + h0 + 4);
        const float dv[8] = {dva[0], dva[1], dva[2], dva[3], dvb[0], dvb[1], dvb[2], dvb[3]};
#pragma unroll
        for (int ai = 0; ai < 2; ++ai) {
            u32x4 uw[4][2];
#pragma unroll
            for (int m = 0; m < 4; ++m) {
                const int ch = (2 * u.pm + ai) * CPB + 1 + wr * 64 + m * 16 + fr;
#pragma unroll
                for (int bj = 0; bj < 2; ++bj) { const int t = bj * 8 + wc * 2 + (fq >> 1); uw[m][bj] = *(const u32x4*)(xs5 + ((size_t)g * NCH + ch) * XS_LD + t * 16 + h0); }
            }
#pragma unroll
            for (int m = 0; m < 4; ++m) {
                const int ch = (2 * u.pm + ai) * CPB + 1 + wr * 64 + m * 16 + fr;
#pragma unroll
                for (int bj = 0; bj < 2; ++bj) {
                    const int t = bj * 8 + wc * 2 + (fq >> 1);
                    float uv[8]; unpack8(uw[m][bj], uv);
                    f32x4 o0, o1;
#pragma unroll
                    for (int j = 0; j < 4; ++j) { o0[j] = gelu_tanh(acc[ai][bj][m][0][j] + dv[j] * uv[j]); o1[j] = gelu_tanh(acc[ai][bj][m][1][j] + dv[4 + j] * uv[4 + j]); }
                    *(u32x4*)(y + ((size_t)ch * 16 + t) * 1024 + g * 16 + h0) = pack8(o0, o1);
                }
            }
        }
    }
};
template <int MODE> struct EpiRow {
    const bf16_t* in; bf16_t* out; const float* rs1;
    __device__ __forceinline__ void operator()(Acc& acc, const Unit& u, int wr, int wc, int fr, int fq) const {
        const int row0 = u.pm * 256 + wr * 64 + fr, c0 = (u.pn & 3) * 256 + wc * 32 + fq * 8;
        bf16_t* o = out + (MODE == 1 ? (size_t)(u.pn >> 2) * (UB / 2) : 0);
        u32x4 vin[2][2][2], win[2][2][2]; float rsv[2][2];
#define EPIROW_LOAD(B) do { const int ai_ = (B) >> 1, mp_ = (B) & 1; _Pragma("unroll") for (int mm = 0; mm < 2; ++mm) { const int row = row0 + ai_ * 128 + (mp_ * 2 + mm) * 16; \
            if (MODE == 1) rsv[(B) & 1][mm] = rs1[row]; \
            _Pragma("unroll") for (int bj = 0; bj < 2; ++bj) { const size_t off = (size_t)row * 1024 + c0 + bj * 128; \
                if (MODE == 0 || MODE == 2 || MODE == 3) vin[(B) & 1][mm][bj] = *(const u32x4*)(in + off); \
                if (MODE == 3) win[(B) & 1][mm][bj] = *(const u32x4*)(o + off); } } } while (0)
        EPIROW_LOAD(0);
#pragma unroll
        for (int b = 0; b < 4; ++b) {
            if (b + 1 < 4) EPIROW_LOAD(b + 1);
            const int ai = b >> 1, mp = b & 1;
#pragma unroll
            for (int mm = 0; mm < 2; ++mm) {
                const int m = mp * 2 + mm; const int row = row0 + ai * 128 + m * 16;
#pragma unroll
                for (int bj = 0; bj < 2; ++bj) {
                    const size_t off = (size_t)row * 1024 + c0 + bj * 128;
                    f32x4 a0 = acc[ai][bj][m][0], a1 = acc[ai][bj][m][1];
                    if (MODE == 0) { float v[8]; unpack8(vin[b & 1][mm][bj], v);
#pragma unroll
                        for (int j = 0; j < 4; ++j) { a0[j] = v[j] * sigm(a0[j]); a1[j] = v[4 + j] * sigm(a1[j]); } }
                    if (MODE == 1) { const float rs = rsv[b & 1][mm];
#pragma unroll
                        for (int j = 0; j < 4; ++j) { a0[j] = sigm(rs * a0[j]); a1[j] = sigm(rs * a1[j]); } }
                    if (MODE == 2) { float v[8]; unpack8(vin[b & 1][mm][bj], v);
#pragma unroll
                        for (int j = 0; j < 4; ++j) { a0[j] = v[j] * a0[j]; a1[j] = v[4 + j] * a1[j]; } }
                    if (MODE == 3) { float v[8], w[8]; unpack8(vin[b & 1][mm][bj], v); unpack8(win[b & 1][mm][bj], w);
#pragma unroll
                        for (int j = 0; j < 4; ++j) { a0[j] = w[j] + v[j] * a0[j]; a1[j] = w[4 + j] + v[4 + j] * a1[j]; } }
                    *(u32x4*)(o + off) = pack8(a0, a1);
                }
            }
        }
#undef EPIROW_LOAD
    }
};
struct EpiGluGates {
    EpiRow<0> e0; EpiRow<1> e1;
    __device__ __forceinline__ void operator()(Acc& acc, const Unit& u, int wr, int wc, int fr, int fq) const {
        if (u.pn < 4) e0(acc, u, wr, wc, fr, fq); else { Unit u2 = u; u2.pn -= 4; e1(acc, u2, wr, wc, fr, fq); }
    }
};
struct EpiOut {
    const float* x; const float* meta; bf16_t* h2b; float* ssq;
    __device__ __forceinline__ void operator()(Acc& acc, const Unit& u, int wr, int wc, int fr, int fq) const {
        const int row0 = u.pm * 256 + wr * 64 + fr, c0 = u.pn * 256 + wc * 32 + fq * 8;
        f32x4 hv[2][2][2][2];
#define EPIOUT_LOAD(B) do { const int ai_ = (B) >> 1, mp_ = (B) & 1; _Pragma("unroll") for (int mm = 0; mm < 2; ++mm) { const int row = row0 + ai_ * 128 + (mp_ * 2 + mm) * 16; const int b_ = row / LTOK, t_ = row - b_ * LTOK; \
            const float* hp = (t_ < NMETA) ? meta + (size_t)t_ * 1024 : x + ((size_t)b_ * SEQ + (t_ - NMETA)) * 1024; \
            _Pragma("unroll") for (int bj = 0; bj < 2; ++bj) { hv[(B) & 1][mm][bj][0] = *(const f32x4*)(hp + c0 + bj * 128); hv[(B) & 1][mm][bj][1] = *(const f32x4*)(hp + c0 + bj * 128 + 4); } } } while (0)
        EPIOUT_LOAD(0);
#pragma unroll
        for (int b = 0; b < 4; ++b) {
            if (b + 1 < 4) EPIOUT_LOAD(b + 1);
            const int ai = b >> 1, mp = b & 1;
#pragma unroll
            for (int mm = 0; mm < 2; ++mm) {
                const int m = mp * 2 + mm; const int row = row0 + ai * 128 + m * 16;
                float ss = 0.f;
#pragma unroll
                for (int bj = 0; bj < 2; ++bj) {
                    const int c = c0 + bj * 128;
                    const f32x4 a0 = acc[ai][bj][m][0] + hv[b & 1][mm][bj][0], a1 = acc[ai][bj][m][1] + hv[b & 1][mm][bj][1];
                    *(u32x4*)(h2b + (size_t)row * 1024 + c) = pack8(a0, a1);
#pragma unroll
                    for (int j = 0; j < 4; ++j) ss += a0[j] * a0[j] + a1[j] * a1[j];
                }
                ss = xsum_rows(ss);
                if (fq == 0) ssq[(size_t)row * 16 + u.pn * 4 + wc] = ss;
            }
        }
#undef EPIOUT_LOAD
    }
};
struct EpiDown {
    const bf16_t* h2b; bf16_t* h3b; float* ssq; int pm_off;
    __device__ __forceinline__ void operator()(Acc& acc, const Unit& u, int wr, int wc, int fr, int fq) const {
        const int row0 = (u.pm + pm_off) * 256 + wr * 64 + fr, c0 = u.pn * 256 + wc * 32 + fq * 8;
        u32x4 hv[2][2][2];
#define EPIDN_LOAD(B) do { const int ai_ = (B) >> 1, mp_ = (B) & 1; _Pragma("unroll") for (int mm = 0; mm < 2; ++mm) { const int row = row0 + ai_ * 128 + (mp_ * 2 + mm) * 16; \
            _Pragma("unroll") for (int bj = 0; bj < 2; ++bj) hv[(B) & 1][mm][bj] = *(const u32x4*)(h2b + (size_t)row * 1024 + c0 + bj * 128); } } while (0)
        EPIDN_LOAD(0);
#pragma unroll
        for (int b = 0; b < 4; ++b) {
            if (b + 1 < 4) EPIDN_LOAD(b + 1);
            const int ai = b >> 1, mp = b & 1;
#pragma unroll
            for (int mm = 0; mm < 2; ++mm) {
                const int m = mp * 2 + mm; const int row = row0 + ai * 128 + m * 16; float ss = 0.f;
#pragma unroll
                for (int bj = 0; bj < 2; ++bj) {
                    float rv[8]; unpack8(hv[b & 1][mm][bj], rv);
                    const f32x4 a0 = acc[ai][bj][m][0] + (f32x4){rv[0], rv[1], rv[2], rv[3]}, a1 = acc[ai][bj][m][1] + (f32x4){rv[4], rv[5], rv[6], rv[7]};
                    *(u32x4*)(h3b + (size_t)row * 1024 + c0 + bj * 128) = pack8(a0, a1);
#pragma unroll
                    for (int j = 0; j < 4; ++j) ss += a0[j] * a0[j] + a1[j] * a1[j];
                }
                ss = xsum_rows(ss);
                if (fq == 0) ssq[(size_t)row * 16 + u.pn * 4 + wc] = ss;
            }
        }
#undef EPIDN_LOAD
    }
};
struct EpiUp {
    const float* ssq2; const float* cw; const float* cb; bf16_t* act; LAS float* halo;
    __device__ __forceinline__ void operator()(Acc& acc, const Unit& u, int wr, int wc, int fr, int fq) const {
        const int grow0 = u.pm * UP_STRIDE - 2 + wr * 64 + fr;
        {
            f32x4 sq[2][4];
            FOR_AI_M { const int grow = grow0 + ai * 128 + m * 16; const int gc = grow < 0 ? 0 : (grow >= M ? M - 1 : grow); sq[ai][m] = *(const f32x4*)(ssq2 + (size_t)gc * 16 + fq * 4); }
            FOR_AI_M {
                const int grow = grow0 + ai * 128 + m * 16;
                float sv = (sq[ai][m][0] + sq[ai][m][1]) + (sq[ai][m][2] + sq[ai][m][3]);
                sv = xsum_rows(sv);
                const float rs = (grow >= 0 && grow < M) ? __builtin_amdgcn_rsqf(sv * (1.f / 1024.f) + EPS) : 0.f;
                FOR_BJ { acc[ai][bj][m][0] *= rs; acc[ai][bj][m][1] *= rs; }
            }
        }
        const int cl = wc * 32 + fq * 8;
#pragma unroll
        for (int ai = 0; ai < 2; ++ai) { const int rg = 2 * ai + wr;
            if (rg <= 2 && fr >= 14) { FOR_BJ { LAS float* hp = halo + (rg * 2 + (fr - 14)) * 256 + bj * 128 + cl; *(LAS f32x4*)hp = acc[ai][bj][3][0]; *(LAS f32x4*)(hp + 4) = acc[ai][bj][3][1]; } } }
        f32x4 cwv[2][2][4];
#pragma unroll
        for (int bj = 0; bj < 2; ++bj)
#pragma unroll
            for (int n = 0; n < 2; ++n) { const int c = bj * DFF + u.pn * 128 + cl + n * 4; cwv[bj][n][0] = *(const f32x4*)(cw + c); cwv[bj][n][1] = *(const f32x4*)(cw + NUP + c); cwv[bj][n][2] = *(const f32x4*)(cw + 2 * NUP + c); cwv[bj][n][3] = *(const f32x4*)(cb + c); }
        asm volatile("s_waitcnt lgkmcnt(0)" ::: "memory"); __builtin_amdgcn_s_barrier(); asm volatile("" ::: "memory");
#ifndef UPTEST_NOCONV
        const int tfirst = u.pm * UP_STRIDE - 2, tmod = ((tfirst % LTOK) + LTOK) % LTOK; const bool has_start = (tmod <= 1) || (tmod + 255 >= LTOK);
        int tp[2][4];
        FOR_AI_M { const int grow = grow0 + ai * 128 + m * 16; tp[ai][m] = (has_start && grow >= 0) ? grow % LTOK : 2; }
#pragma unroll
        for (int bj = 0; bj < 2; ++bj)
#pragma unroll
            for (int n = 0; n < 2; ++n) {
                const f32x4 w0 = cwv[bj][n][0], w1 = cwv[bj][n][1], w2 = cwv[bj][n][2], bb = cwv[bj][n][3];
#pragma unroll
                for (int ai = 0; ai < 2; ++ai)
#pragma unroll
                    for (int mm = 0; mm < 4; ++mm) {
                        const int m = 3 - mm;
                        const f32x4 cur = acc[ai][bj][m][n]; f32x4 p1, p2, q1, q2;
                        if (m > 0) {
                            const f32x4 pv = acc[ai][bj][m - 1][n];
#pragma unroll
                            for (int j = 0; j < 4; ++j) { q1[j] = dpp_f<0x121>(pv[j]); q2[j] = dpp_f<0x122>(pv[j]); }
                        } else {
                            const int rg = 2 * ai + wr;
                            if (rg >= 1) { const LAS float* hp = halo + ((rg - 1) * 2) * 256 + bj * 128 + cl + n * 4; q1 = *(const LAS f32x4*)(hp + 256); q2 = *(const LAS f32x4*)(hp + (fr == 0 ? 0 : 256)); }
                            else { q1 = (f32x4){0.f, 0.f, 0.f, 0.f}; q2 = q1; }
                        }
#pragma unroll
                        for (int j = 0; j < 4; ++j) { p1[j] = dpp_fo<0x111>(q1[j], cur[j]); p2[j] = dpp_fo<0x112>(q2[j], cur[j]); }
                        if (has_start) {
                            const int t = tp[ai][m];
                            if (t < 1) p1 = (f32x4){0.f, 0.f, 0.f, 0.f};
                            if (t < 2) p2 = (f32x4){0.f, 0.f, 0.f, 0.f};
                        }
                        acc[ai][bj][m][n] = bb + w0 * p2 + w1 * p1 + w2 * cur;
                        asm volatile("" : "+v"(acc[ai][bj][m][n]));
                    }
            }
#endif
        FOR_AI_M {
            const int grow = grow0 + ai * 128 + m * 16; const int r = ai * 128 + wr * 64 + m * 16 + fr;
            if (r >= 2 && grow < M) {
                f32x4 o0, o1;
#pragma unroll
                for (int j = 0; j < 4; ++j) { const float a = acc[ai][0][m][0][j], b = acc[ai][0][m][1][j]; o0[j] = a * sigm(a) * acc[ai][1][m][0][j]; o1[j] = b * sigm(b) * acc[ai][1][m][1][j]; }
                *(u32x4*)(act + (size_t)grow * DFF + u.pn * 128 + cl) = pack8(o0, o1);
            }
        }
    }
};

struct Params {
    const float *x, *meta, *mix_g, *w_in, *lam_re, *lam_im, *log_dt, *b_re, *b_im, *c_re, *c_im, *ssm_d, *w_glu, *w_ssm, *lb_logits, *hg_norm, *w_hg, *w_out, *ffn_g, *w_up, *conv_w, *conv_b, *w_down, *fin_g;
    float* out; unsigned char* ws; int ph_lo, ph_hi;
};

__device__ __forceinline__ void transpose_item(const float* src, int N, int Kd, bf16_t* dst, int drow0, int scol0, int k0, const float* scale, LAS float* scr, int lane) {
#pragma unroll 8
    for (int i = 0; i < 32; ++i) { const int kk = 2 * i + (lane >> 5); float v = src[(size_t)(k0 + kk) * N + scol0 + (lane & 31)]; if (scale) v *= scale[k0 + kk]; scr[kk * 33 + (lane & 31)] = v; }
    asm volatile("s_waitcnt lgkmcnt(0)" ::: "memory");
    const int c = lane & 7;
#pragma unroll
    for (int j = 0; j < 4; ++j) { const int n = (lane >> 3) + 8 * j; const LAS float* s = scr + (8 * c) * 33 + n;
        u32x4 o; o.x = cvt_pk_bf16(s[0 * 33], s[1 * 33]); o.y = cvt_pk_bf16(s[2 * 33], s[3 * 33]); o.z = cvt_pk_bf16(s[4 * 33], s[5 * 33]); o.w = cvt_pk_bf16(s[6 * 33], s[7 * 33]);
        *(u32x4*)(dst + (size_t)(drow0 + n) * Kd + k0 + 8 * c) = o; }
    asm volatile("s_waitcnt lgkmcnt(0)" ::: "memory");
}
__device__ __forceinline__ void sincos_d(double a, float& s, float& c) {
    const double q = rint(a * 0.63661977236758134308);
    const double r = fma(-q, 1.57079632679489661923, a) - q * 6.12323399573676603587e-17;
    const double r2 = r * r;
    double sp = -7.6471637318198164759e-13; sp = fma(sp, r2, 1.6059043836821614599e-10); sp = fma(sp, r2, -2.5052108385441718775e-8); sp = fma(sp, r2, 2.7557319223985890653e-6);
    sp = fma(sp, r2, -1.9841269841269841270e-4); sp = fma(sp, r2, 8.3333333333333333333e-3); sp = fma(sp, r2, -1.6666666666666666667e-1); sp = fma(sp * r2, r, r);
    double cp = 4.7794773323873852974e-14; cp = fma(cp, r2, -1.1470745597729724714e-11); cp = fma(cp, r2, 2.0876756987868098979e-9); cp = fma(cp, r2, -2.7557319223985890653e-7);
    cp = fma(cp, r2, 2.4801587301587301587e-5); cp = fma(cp, r2, -1.3888888888888888889e-3); cp = fma(cp, r2, 4.1666666666666666667e-2); cp = fma(cp, r2, -0.5); cp = fma(cp, r2, 1.0);
    const int k = ((int)(long long)q) & 3;
    const double ss = (k & 1) ? cp : sp, cc = (k & 1) ? sp : cp;
    s = (float)((k & 2) ? -ss : ss); c = (float)(((k + 1) & 2) ? -cc : cc);
}
__device__ __forceinline__ void s5_build(const Params& p, int g, LAS unsigned char* lds, const int tid) {
    LAS float* apr = (LAS float*)lds;
    LAS float* api = apr + 17 * 64;
    LAS float* bbr = api + 17 * 64;
    LAS float* bbi = bbr + 1024;
    LAS float* cr = bbi + 1024;
    LAS float* ci = cr + 1024;
    LAS float* cfr = ci + 1024;
    LAS float* cfi = cfr + 64;
    LAS float* ktab = cfi + 64;
    const float dt = expf(p.log_dt[g]);
    for (int idx = tid; idx < 17 * 64; idx += 512) {
        const int tau = idx >> 6, pp = idx & 63; const float lr = p.lam_re[g * 64 + pp], li = p.lam_im[g * 64 + pp];
        const float mag = expf(lr * dt * (float)tau); float s, c; sincos_d((double)li * (double)dt * (double)tau, s, c);
        apr[idx] = mag * c; api[idx] = mag * s;
    }
    for (int idx = tid; idx < 1024; idx += 512) { cr[idx] = p.c_re[g * 1024 + idx]; ci[idx] = p.c_im[g * 1024 + idx]; }
    __syncthreads();
    if (tid < 64) {
        const float lr = p.lam_re[g * 64 + tid], li = p.lam_im[g * 64 + tid]; const float ar = apr[64 + tid], ai = api[64 + tid];
        const float den = lr * lr + li * li, nr = ar - 1.f;
        cfr[tid] = (nr * lr + ai * li) / den; cfi[tid] = (ai * lr - nr * li) / den;
        float* a16 = (float*)(p.ws + SM_A16) + (g * 64 + tid) * 2; a16[0] = apr[16 * 64 + tid]; a16[1] = api[16 * 64 + tid];
    }
    __syncthreads();
    for (int idx = tid; idx < 1024; idx += 512) { const int pp = idx >> 4; const float br = p.b_re[g * 1024 + idx], bi = p.b_im[g * 1024 + idx];
        bbr[idx] = cfr[pp] * br - cfi[pp] * bi; bbi[idx] = cfr[pp] * bi + cfi[pp] * br; }
    __syncthreads();
    for (int idx = tid; idx < 4096; idx += 512) {
        const int tau = idx >> 8, h = (idx >> 4) & 15, h2 = idx & 15; float s = 0.f;
        for (int pp = 0; pp < 64; ++pp) { const float zr = cr[h * 64 + pp] * apr[tau * 64 + pp] - ci[h * 64 + pp] * api[tau * 64 + pp], zi = cr[h * 64 + pp] * api[tau * 64 + pp] + ci[h * 64 + pp] * apr[tau * 64 + pp];
            s += zr * bbr[pp * 16 + h2] - zi * bbi[pp * 16 + h2]; }
        ktab[idx] = s;
    }
    __syncthreads();
    unsigned* KE = (unsigned*)(p.ws + W_KE) + (size_t)g * 256 * 192;
    for (int q = tid; q < 256 * 192; q += 512) {
        const int row = q / 192, col = (q - row * 192) * 2, t = row >> 4, h = row & 15; float v0, v1;
        if (col < 256) { const int s = col >> 4, h2 = col & 15; if (s <= t) { v0 = ktab[((t - s) * 16 + h) * 16 + h2]; v1 = ktab[((t - s) * 16 + h) * 16 + h2 + 1]; } else { v0 = 0.f; v1 = 0.f; } }
        else { const int j = col - 256; float e[2];
#pragma unroll
            for (int i = 0; i < 2; ++i) { const int jj = (j + i) & 63; const float crr = cr[h * 64 + jj], cii = ci[h * 64 + jj], ar = apr[(t + 1) * 64 + jj], ai = api[(t + 1) * 64 + jj];
                e[i] = (j + i < 64) ? (crr * ar - cii * ai) : -(crr * ai + cii * ar); }
            v0 = e[0]; v1 = e[1]; }
        KE[q] = cvt_pk_bf16(v0, v1);
    }
    unsigned* W5 = (unsigned*)(p.ws + W_W5) + (size_t)g * 256 * 128;
    for (int q = tid; q < 256 * 128; q += 512) {
        const int j = q >> 7, col = (q & 127) * 2, s = col >> 4, h2 = col & 15; float v[2] = {0.f, 0.f};
        if (j < 128) { const int jj = j & 63; const float ar = apr[(15 - s) * 64 + jj], ai = api[(15 - s) * 64 + jj];
#pragma unroll
            for (int i = 0; i < 2; ++i) { const float br = bbr[jj * 16 + h2 + i], bi = bbi[jj * 16 + h2 + i]; v[i] = (j < 64) ? (ar * br - ai * bi) : (ar * bi + ai * br); } }
        W5[q] = cvt_pk_bf16(v[0], v[1]);
    }
    __syncthreads();
}
__device__ __forceinline__ int win_src_col(int n) {
    if (n < 1024 || n >= 3072) return n;
    const int r = n - 1024, hh = r >> 8, rr = r & 255; return rr < 128 ? 1024 + hh * 128 + rr : 2048 + hh * 128 + (rr - 128);
}
__device__ __forceinline__ int wup_src_col(int n) { const int pn = n >> 8, rr = n & 255; return rr < 128 ? pn * 128 + rr : DFF + pn * 128 + (rr - 128); }

__device__ __forceinline__ void phase_prep(const Params& p, LAS unsigned char* lds, const int wv) {
    const int tid = wv * 64 + lane_id_v(), lane = tid & 63, wave = tid >> 6, G = gridDim.x;
    for (int g = blockIdx.x; g < 64; g += G) s5_build(p, g, lds, tid);
    LAS float* scr = (LAS float*)(lds + wave * 16384);
    const int gw = blockIdx.x * 8 + wave, NGW = G * 8;
    constexpr int I_IN = 16 * (NIN / 32), I_SQ = 16 * 32, I_UP = 16 * (NUP / 32), I_DN = (DFF / 64) * 32;
    constexpr int NIT = I_IN + 4 * I_SQ + I_UP + I_DN;
    unsigned char* ws = p.ws;
    for (int it = gw; it < NIT; it += NGW) {
        int r = it;
        if (r < I_IN) { const int nb = r % (NIN / 32), kb = r / (NIN / 32); transpose_item(p.w_in, NIN, 1024, (bf16_t*)(ws + W_WIN), nb * 32, win_src_col(nb * 32), kb * 64, p.mix_g, scr, lane); continue; } r -= I_IN;
        if (r < 4 * I_SQ) { const int w = r / I_SQ, rr = r % I_SQ, nb = rr % 32, kb = rr / 32;
            const float* src = w == 0 ? p.w_glu : w == 1 ? p.w_ssm : w == 2 ? p.w_hg : p.w_out; bf16_t* dst = (bf16_t*)(ws + (w == 0 ? W_GLU : w == 1 ? W_A : w == 2 ? W_B : W_O));
            transpose_item(src, 1024, 1024, dst, nb * 32, nb * 32, kb * 64, nullptr, scr, lane); continue; } r -= 4 * I_SQ;
        if (r < I_UP) { const int nb = r % (NUP / 32), kb = r / (NUP / 32); transpose_item(p.w_up, NUP, 1024, (bf16_t*)(ws + W_UP), nb * 32, wup_src_col(nb * 32), kb * 64, p.ffn_g, scr, lane); continue; } r -= I_UP;
        { const int nb = r % 32, kb = r / 32; transpose_item(p.w_down, 1024, DFF, (bf16_t*)(ws + W_DN), nb * 32, nb * 32, kb * 64, nullptr, scr, lane); }
    }
    bf16_t* xb = (bf16_t*)(ws + SLOT(2)); float* rs1 = (float*)(ws + SM_RS1);
    {
        f32x4 v[4], vn[4];
        int row = gw;
        if (row < M) { const int b = row / LTOK, t = row - b * LTOK; const float* hp = (t < NMETA) ? p.meta + (size_t)t * 1024 : p.x + ((size_t)b * SEQ + (t - NMETA)) * 1024;
#pragma unroll
            for (int j = 0; j < 4; ++j) v[j] = __builtin_nontemporal_load((const f32x4*)(hp + (lane + 64 * j) * 4)); }
        for (; row < M; row += NGW) {
            const int nrow = row + NGW;
            if (nrow < M) { const int b = nrow / LTOK, t = nrow - b * LTOK; const float* hp = (t < NMETA) ? p.meta + (size_t)t * 1024 : p.x + ((size_t)b * SEQ + (t - NMETA)) * 1024;
#pragma unroll
                for (int j = 0; j < 4; ++j) vn[j] = __builtin_nontemporal_load((const f32x4*)(hp + (lane + 64 * j) * 4)); }
            float s = 0.f;
#pragma unroll
            for (int j = 0; j < 4; ++j) s += (v[j][0] * v[j][0] + v[j][1] * v[j][1]) + (v[j][2] * v[j][2] + v[j][3] * v[j][3]);
            s = wave_sum(s);
            if (lane == 0) rs1[row] = __builtin_amdgcn_rsqf(s * (1.f / 1024.f) + EPS);
#pragma unroll
            for (int j = 0; j < 4; ++j) { u32x2 w; w.x = cvt_pk_bf16(v[j][0], v[j][1]); w.y = cvt_pk_bf16(v[j][2], v[j][3]); *(u32x2*)(xb + (size_t)row * 1024 + (lane + 64 * j) * 4) = w; }
#pragma unroll
            for (int j = 0; j < 4; ++j) v[j] = vn[j];
        }
    }
}

__device__ __forceinline__ f32x4 mfma_k16(const bf16x4 a, const bf16x4 b, const f32x4 c) {
    const bf16x4 z = (bf16x4){0, 0, 0, 0};
    return __builtin_amdgcn_mfma_f32_16x16x32_bf16(__builtin_shufflevector(a, z, 0, 1, 2, 3, 4, 5, 6, 7), __builtin_shufflevector(b, z, 0, 1, 2, 3, 4, 5, 6, 7), c, 0, 0, 0);
}
constexpr int HB_QI = 0, HB_KI = 4608, HB_KIT = 9216, HB_VT = 14336, HB_DEC = 19456, HB_SIZE = 20480;
constexpr int HB_O = 2 * HB_SIZE, HB_OSZ = 16 * 132 * 4;
__device__ __forceinline__ float row16_sum(float x) {
    x += dpp_f<0xB1>(x); x += dpp_f<0x4E>(x); x += dpp_f<0x141>(x); x += dpp_f<0x140>(x); return x;
}
__device__ __forceinline__ void phase_hgrn(const Params& p, LAS unsigned char* lds, const int wv) {
    const int lane = lane_id_v(), fr = lane & 15, fq = lane >> 4;
    const bf16_t* qi = (const bf16_t*)(p.ws + SLOT(3)); const bf16_t* ki = (const bf16_t*)(p.ws + SLOT(4)); const bf16_t* vb = (const bf16_t*)(p.ws + SLOT(5)); const bf16_t* ogb = (const bf16_t*)(p.ws + SLOT(6));
    const float* dec = (const float*)(p.ws + SM_DEC); bf16_t* yb = (bf16_t*)p.out;
    for (int bh = blockIdx.x; bh < BATCH * 8; bh += gridDim.x) {
        const int b = bh >> 3, hh = bh & 7;
        if (wv >= 4) {
            const int ptid = (wv - 4) * 64 + lane, t = ptid >> 4, c8 = (ptid & 15) * 8;
            const size_t goff0 = ((size_t)b * LTOK + t) * 1024 + hh * 128 + c8;
            const float* decp = dec + (size_t)(b * CPB) * 1024 + hh * 128 + (ptid & 127);
            const f32x4 ng0 = *(const f32x4*)(p.hg_norm + c8), ng1 = *(const f32x4*)(p.hg_norm + c8 + 4);
            u32x4 rq[3], rk[3], rv[3], ogr[3]; float rdec[3];
#pragma unroll
            for (int j = 0; j < 3; ++j) { const size_t go = goff0 + (size_t)j * 16384;
                rq[j] = *(const u32x4*)(qi + go); rk[j] = *(const u32x4*)(ki + go); rv[j] = *(const u32x4*)(vb + go); rdec[j] = (ptid < 128) ? decp[(size_t)j * 1024] : 0.f; }
            ogr[0] = *(const u32x4*)(ogb + goff0); ogr[1] = *(const u32x4*)(ogb + goff0 + 16384); ogr[2] = ogr[0];
#define HG_W(CH, SET) do { LAS unsigned char* buf_ = lds + ((CH) & 1) * HB_SIZE; \
                *(LAS u32x4*)(buf_ + HB_QI + t * 288 + c8 * 2) = rq[SET]; *(LAS u32x4*)(buf_ + HB_KI + t * 288 + c8 * 2) = rk[SET]; \
                LAS unsigned short* kt_ = (LAS unsigned short*)(buf_ + HB_KIT) + c8 * 20 + t; LAS unsigned short* vt_ = (LAS unsigned short*)(buf_ + HB_VT) + c8 * 20 + t; \
                const unsigned kw_[4] = {rk[SET].x, rk[SET].y, rk[SET].z, rk[SET].w}, vw_[4] = {rv[SET].x, rv[SET].y, rv[SET].z, rv[SET].w}; \
                _Pragma("unroll") for (int i_ = 0; i_ < 4; ++i_) { kt_[(2 * i_) * 20] = (unsigned short)(kw_[i_] & 0xffff); kt_[(2 * i_ + 1) * 20] = (unsigned short)(kw_[i_] >> 16); \
                    vt_[(2 * i_) * 20] = (unsigned short)(vw_[i_] & 0xffff); vt_[(2 * i_ + 1) * 20] = (unsigned short)(vw_[i_] >> 16); } \
                if (ptid < 128) ((LAS float*)(buf_ + HB_DEC))[ptid] = rdec[SET]; \
                if ((CH) + 3 < CPB) { const size_t go_ = goff0 + (size_t)((CH) + 3) * 16384; \
                    rq[SET] = *(const u32x4*)(qi + go_); rk[SET] = *(const u32x4*)(ki + go_); rv[SET] = *(const u32x4*)(vb + go_); if (ptid < 128) rdec[SET] = decp[(size_t)((CH) + 3) * 1024]; } } while (0)
#define HG_N(CH, SET) do { const LAS float* ob_ = (const LAS float*)(lds + HB_O + ((CH) & 1) * HB_OSZ) + t * 132 + c8; \
                const f32x4 o0_ = *(const LAS f32x4*)ob_, o1_ = *(const LAS f32x4*)(ob_ + 4); \
                float ss_ = ((o0_[0] * o0_[0] + o0_[1] * o0_[1]) + (o0_[2] * o0_[2] + o0_[3] * o0_[3])) + ((o1_[0] * o1_[0] + o1_[1] * o1_[1]) + (o1_[2] * o1_[2] + o1_[3] * o1_[3])); \
                ss_ = row16_sum(ss_); const float rs_ = __builtin_amdgcn_rsqf(ss_ * (1.f / 128.f) + EPS); \
                float g_[8]; unpack8(ogr[SET], g_); f32x4 r0_, r1_; \
                _Pragma("unroll") for (int i_ = 0; i_ < 4; ++i_) { r0_[i_] = o0_[i_] * rs_ * ng0[i_] * (g_[i_] * sigm(g_[i_])); r1_[i_] = o1_[i_] * rs_ * ng1[i_] * (g_[4 + i_] * sigm(g_[4 + i_])); } \
                *(u32x4*)(yb + goff0 + (size_t)(CH) * 16384) = pack8(r0_, r1_); } while (0)
            HG_W(0, 0);
            __syncthreads();
            for (int c0 = 0; c0 < CPB; c0 += 3) {
#pragma unroll
                for (int j = 0; j < 3; ++j) {
                    const int c = c0 + j;
                    if (c > 0) HG_N(c - 1, (j + 2) % 3);
                    if (c + 2 < CPB) ogr[(j + 2) % 3] = *(const u32x4*)(ogb + goff0 + (size_t)(c + 2) * 16384);
                    if (c + 1 < CPB) HG_W(c + 1, (j + 1) % 3);
                    __syncthreads();
                }
            }
            HG_N(CPB - 1, (CPB - 1) % 3);
#undef HG_W
#undef HG_N
        } else {
            __builtin_amdgcn_s_setprio(3);
            const int w = wv;
            f32x4 S[8][2];
#pragma unroll
            for (int i = 0; i < 8; ++i) { S[i][0] = (f32x4){0.f, 0.f, 0.f, 0.f}; S[i][1] = S[i][0]; }
            __syncthreads();
            for (int c = 0; c < CPB; ++c) {
                const LAS unsigned char* buf = lds + (c & 1) * HB_SIZE;
                bf16x8 qf[4], kf[4];
#pragma unroll
                for (int kk = 0; kk < 4; ++kk) {
                    const LAS unsigned char* qp = buf + HB_QI + fr * 288 + (32 * kk + 4 * fq) * 2; const LAS unsigned char* kp = buf + HB_KI + fr * 288 + (32 * kk + 4 * fq) * 2;
                    const bf16x4 q0 = *(const LAS bf16x4*)qp, q1 = *(const LAS bf16x4*)(qp + 32), k0 = *(const LAS bf16x4*)kp, k1 = *(const LAS bf16x4*)(kp + 32);
                    qf[kk] = __builtin_shufflevector(q0, q1, 0, 1, 2, 3, 4, 5, 6, 7); kf[kk] = __builtin_shufflevector(k0, k1, 0, 1, 2, 3, 4, 5, 6, 7);
                }
                f32x4 sT = (f32x4){0.f, 0.f, 0.f, 0.f};
#pragma unroll
                for (int kk = 0; kk < 4; ++kk) sT = __builtin_amdgcn_mfma_f32_16x16x32_bf16(kf[kk], qf[kk], sT, 0, 0, 0);
#pragma unroll
                for (int j = 0; j < 4; ++j) sT[j] = (4 * fq + j <= fr) ? sT[j] : 0.f;
                bf16x4 P; { const unsigned a = cvt_pk_bf16(sT[0], sT[1]), bq = cvt_pk_bf16(sT[2], sT[3]); P[0] = (short)(a & 0xffff); P[1] = (short)(a >> 16); P[2] = (short)(bq & 0xffff); P[3] = (short)(bq >> 16); }
                bf16x4 vf[2]; f32x4 o[2];
#pragma unroll
                for (int nt = 0; nt < 2; ++nt) { vf[nt] = *(const LAS bf16x4*)(buf + HB_VT + (32 * w + 16 * nt + fr) * 40 + fq * 8); o[nt] = mfma_k16(P, vf[nt], (f32x4){0.f, 0.f, 0.f, 0.f}); }
#pragma unroll
                for (int kk = 0; kk < 4; ++kk)
#pragma unroll
                    for (int nt = 0; nt < 2; ++nt) {
                        const u32x4 sw = pack8(S[2 * kk][nt], S[2 * kk + 1][nt]);
                        bf16x8 bs; bs[0] = (short)(sw.x & 0xffff); bs[1] = (short)(sw.x >> 16); bs[2] = (short)(sw.y & 0xffff); bs[3] = (short)(sw.y >> 16);
                        bs[4] = (short)(sw.z & 0xffff); bs[5] = (short)(sw.z >> 16); bs[6] = (short)(sw.w & 0xffff); bs[7] = (short)(sw.w >> 16);
                        o[nt] = __builtin_amdgcn_mfma_f32_16x16x32_bf16(qf[kk], bs, o[nt], 0, 0, 0);
                    }
#pragma unroll
                for (int T = 0; T < 8; ++T) {
                    const bf16x4 kT = *(const LAS bf16x4*)(buf + HB_KIT + (16 * T + fr) * 40 + fq * 8);
                    const f32x4 dv = *(const LAS f32x4*)(buf + HB_DEC + (16 * T + 4 * fq) * 4);
#pragma unroll
                    for (int nt = 0; nt < 2; ++nt) { S[T][nt] = mfma_k16(kT, vf[nt], S[T][nt]); S[T][nt] *= dv; }
                }
                LAS float* ob = (LAS float*)(lds + HB_O + (c & 1) * HB_OSZ);
#pragma unroll
                for (int nt = 0; nt < 2; ++nt)
#pragma unroll
                    for (int j = 0; j < 4; ++j) ob[(4 * fq + j) * 132 + 32 * w + 16 * nt + fr] = o[nt][j];
                __syncthreads();
            }
            __builtin_amdgcn_s_setprio(0);
        }
        __syncthreads();
    }
}

__device__ __forceinline__ void phase_scan(const Params& p, const int wv) {
    const int tid = wv * 64 + lane_id_v();
    {
        const bf16_t* xs = (const bf16_t*)(p.ws + SLOT(0)); const bf16_t* KE = (const bf16_t*)(p.ws + W_KE); bf16_t* y = (bf16_t*)(p.ws + SLOT(4));
        for (int gid = blockIdx.x * 512 + tid; gid < 64 * 256; gid += gridDim.x * 512) {
            const int g = gid >> 8, th = gid & 255, t = th >> 4, h = th & 15;
            const u32x4* kr = (const u32x4*)(KE + ((size_t)g * 256 + th) * 384); const u32x4* ur = (const u32x4*)(xs + (size_t)g * NCH * XS_LD);
            float a = 0.f;
#pragma unroll 4
            for (int k8 = 0; k8 < 32; ++k8) { float kv[8], uv[8]; unpack8(kr[k8], kv); unpack8(ur[k8], uv);
#pragma unroll
                for (int i = 0; i < 8; ++i) a += kv[i] * uv[i]; }
            const float u0 = __uint_as_float((unsigned)xs[(size_t)g * NCH * XS_LD + th] << 16);
            const bf16_t yv = (bf16_t)(cvt_pk_bf16(gelu_tanh(a + p.ssm_d[g * 16 + h] * u0), 0.f) & 0xffff);
            for (int b = 0; b < BATCH; ++b) y[((size_t)b * LTOK + t) * 1024 + g * 16 + h] = yv;
        }
    }
    const bf16_t* L = (const bf16_t*)p.out + UB / 2; bf16_t* xs5 = (bf16_t*)(p.ws + SLOT(0)); const float* a16 = (const float*)(p.ws + SM_A16);
    for (int gid = blockIdx.x * 512 + tid; gid < BATCH * 64 * 64; gid += gridDim.x * 512) {
        const int pp = gid & 63, g = (gid >> 6) & 63, b = gid >> 12;
        const float ar = a16[(g * 64 + pp) * 2], ai = a16[(g * 64 + pp) * 2 + 1];
        float sr = 0.f, si = 0.f;
        const bf16_t* lp = L + ((size_t)g * NCH + (size_t)b * CPB) * 128 + pp; bf16_t* xp = xs5 + ((size_t)g * NCH + (size_t)b * CPB) * XS_LD + 256 + pp;
#pragma unroll 43
        for (int c = 0; c < CPB; ++c) {
            const float lr = (c < CPB - 1) ? __uint_as_float((unsigned)lp[(size_t)c * 128] << 16) : 0.f, li = (c < CPB - 1) ? __uint_as_float((unsigned)lp[(size_t)c * 128 + 64] << 16) : 0.f;
            xp[(size_t)c * XS_LD] = (bf16_t)(cvt_pk_bf16(sr, 0.f) & 0xffff); xp[(size_t)c * XS_LD + 64] = (bf16_t)(cvt_pk_bf16(si, 0.f) & 0xffff);
            const float nr = ar * sr - ai * si + lr, ni = ar * si + ai * sr + li; sr = nr; si = ni;
        }
    }
}

__device__ __forceinline__ void phase_final(const Params& p, const int wv, const int r_begin, const int r_end, const int blk, const int nblk) {
    const bf16_t* h3 = (const bf16_t*)(p.ws + SLOT(0)); const float* ssq = (const float*)(p.ws + SM_SSQ3);
    const int lane = lane_id_v(), gw = blk * 8 + wv, NGW = nblk * 8;
    f32x4 gv[4];
#pragma unroll
    for (int j = 0; j < 4; ++j) gv[j] = *(const f32x4*)(p.fin_g + (lane + 64 * j) * 4);
    {
        u32x2 v[4], vn[4]; f32x4 sq[4], sqn[4];
        int r = r_begin + gw;
        if (r < r_end) { const int b = r / SEQ, t = r - b * SEQ; const size_t row = (size_t)b * LTOK + NMETA + t;
#pragma unroll
            for (int j = 0; j < 4; ++j) { v[j] = __builtin_nontemporal_load((const u32x2*)(h3 + row * 1024 + (lane + 64 * j) * 4)); sq[j] = *(const f32x4*)(ssq + row * 16 + j * 4); } }
        for (; r < r_end; r += NGW) {
            const int nr = r + NGW;
            if (nr < r_end) { const int b = nr / SEQ, t = nr - b * SEQ; const size_t row = (size_t)b * LTOK + NMETA + t;
#pragma unroll
                for (int j = 0; j < 4; ++j) { vn[j] = __builtin_nontemporal_load((const u32x2*)(h3 + row * 1024 + (lane + 64 * j) * 4)); sqn[j] = *(const f32x4*)(ssq + row * 16 + j * 4); } }
            const f32x4 s4 = (sq[0] + sq[1]) + (sq[2] + sq[3]);
            const float rs = __builtin_amdgcn_rsqf(((s4[0] + s4[1]) + (s4[2] + s4[3])) * (1.f / 1024.f) + EPS);
#pragma unroll
            for (int j = 0; j < 4; ++j) { const f32x4 hv = (f32x4){bf_lo(v[j].x), bf_hi(v[j].x), bf_lo(v[j].y), bf_hi(v[j].y)}; __builtin_nontemporal_store(hv * rs * gv[j], (f32x4*)(p.out + (size_t)r * 1024 + (lane + 64 * j) * 4)); }
#pragma unroll
            for (int j = 0; j < 4; ++j) { v[j] = vn[j]; sq[j] = sqn[j]; }
        }
    }
}

__device__ __forceinline__ void grid_bar(unsigned* ctr, unsigned target, const int wv) {
    asm volatile("s_waitcnt vmcnt(0)" ::: "memory");
    __syncthreads();
    if (wv == 0) {
        __builtin_amdgcn_fence(__ATOMIC_RELEASE, "agent");
        if (lane_id_v() == 0) {
            __hip_atomic_fetch_add(ctr, 1u, __ATOMIC_RELAXED, __HIP_MEMORY_SCOPE_AGENT);
            while (__hip_atomic_load(ctr, __ATOMIC_RELAXED, __HIP_MEMORY_SCOPE_AGENT) < target) __builtin_amdgcn_s_sleep(1);
        }
        __builtin_amdgcn_fence(__ATOMIC_ACQUIRE, "agent");
    }
    __syncthreads();
}
constexpr int LDS_HALO = pg8::STAGE_BYTES, LDS_BYTES = pg8::STAGE_BYTES + 8192;
constexpr int N_PHASES = 15;
__global__ void __launch_bounds__(512, 2) mk_fwd(Params p) {
    extern __shared__ __attribute__((aligned(16))) unsigned char lds_raw[];
    LAS unsigned char* lds = (LAS unsigned char*)lds_raw;
    unsigned char* ws = p.ws;
    const int G = gridDim.x, c = blockIdx.x, lo = p.ph_lo, hi = p.ph_hi;
    const int wv = __builtin_amdgcn_readfirstlane((int)(threadIdx.x >> 6));
    unsigned* bar_ctr = (unsigned*)(ws + CTL_OFF); unsigned nbar = 0;
#ifndef ONLY_PHASE
#define ONLY_PHASE -1
#endif
#define IN(k) ((ONLY_PHASE < 0 || ONLY_PHASE == (k)) && lo <= (k) && (k) < hi)
#if MK_PER_PHASE
#define SEAM(k) do { } while (0)
#else
#define SEAM(k) do { if (IN(k) && IN((k) + 1)) { ++nbar; grid_bar(bar_ctr, nbar * (unsigned)G, wv); } } while (0)
#endif
    bf16_t* xs5 = (bf16_t*)(ws + SLOT(0)); bf16_t* xb = (bf16_t*)(ws + SLOT(2));
    const float* rs1 = (const float*)(ws + SM_RS1);
    if (lo + 1 < hi) cg::this_grid().sync();
    if (IN(0)) { phase_prep(p, lds, wv); } SEAM(0);
    if (IN(1)) {
        pg8::Gemm g{xb, (const bf16_t*)(ws + W_WIN), 1024, 1024, 1024}; pg8::TileOrder S; S.init(M / 256, NG1A / 256, G, c, 1024, 1024);
        EpiG1a E{xs5, (bf16_t*)(ws + SLOT(3)), (bf16_t*)(ws + SLOT(4)), (bf16_t*)(ws + SLOT(5)), (bf16_t*)(ws + SLOT(6)), (float*)(ws + SM_DEC), rs1, p.lb_logits};
        pg8::gemm_phase(lds, g, S, E, wv);
    } SEAM(1);
    if (IN(2)) { phase_hgrn(p, lds, wv); }
    if (IN(3)) {
        pg8::Gemm g{xs5, (const bf16_t*)(ws + W_W5), 256, XS_LD, 256, CPB}; pg8::GroupOrder S; S.init(G, c, 256, 0);
        EpiS5i E{(bf16_t*)p.out + UB / 2};
        pg8::gemm_phase(lds, g, S, E, wv);
    } SEAM(3);
    if (IN(4)) { phase_scan(p, wv); } SEAM(4);
    if (IN(5)) {
        pg8::Gemm g{xs5, (const bf16_t*)(ws + W_KE), 384, XS_LD, 384, CPB}; pg8::GroupOrder S; S.init(G, c, 384, 1);
        EpiS5y E{xs5, p.ssm_d, (bf16_t*)(ws + SLOT(4))};
        pg8::gemm_phase(lds, g, S, E, wv);
    } SEAM(5);
    if (IN(6)) {
        pg8::Gemm g{(const bf16_t*)(ws + SLOT(4)), (const bf16_t*)(ws + W_GLU), 1024, 1024, 1024}; pg8::TileOrder S; S.init(M / 256, 12, G, c, 1024, 1024);
        S.split_pn = 4; S.a2_off = (long)SLOT(2) - (long)SLOT(4); S.b2_off = (long)(W_WIN + (size_t)NG1A * 2048) - (long)W_GLU;
        EpiGluGates E{EpiRow<0>{(const bf16_t*)(ws + SLOT(4)), (bf16_t*)(ws + SLOT(5)), nullptr}, EpiRow<1>{nullptr, (bf16_t*)(ws + SLOT(0)), rs1}};
        pg8::gemm_phase(lds, g, S, E, wv);
    } SEAM(6);
    if (IN(8)) {
        pg8::Gemm g{(const bf16_t*)(ws + SLOT(5)), (const bf16_t*)(ws + W_A), 1024, 1024, 1024}; pg8::TileOrder S; S.init(M / 256, 4, G, c, 1024, 1024);
        EpiRow<2> E{(const bf16_t*)(ws + SLOT(0)), (bf16_t*)(ws + SLOT(2)), nullptr};
        pg8::gemm_phase(lds, g, S, E, wv);
    } SEAM(8);
    if (IN(9)) {
        pg8::Gemm g{(const bf16_t*)p.out, (const bf16_t*)(ws + W_B), 1024, 1024, 1024}; pg8::TileOrder S; S.init(M / 256, 4, G, c, 1024, 1024);
        EpiRow<3> E{(const bf16_t*)(ws + SLOT(1)), (bf16_t*)(ws + SLOT(2)), nullptr};
        pg8::gemm_phase(lds, g, S, E, wv);
    } SEAM(9);
    if (IN(10)) {
        pg8::Gemm g{(const bf16_t*)(ws + SLOT(2)), (const bf16_t*)(ws + W_O), 1024, 1024, 1024}; pg8::TileOrder S; S.init(M / 256, 4, G, c, 1024, 1024);
        EpiOut E{p.x, p.meta, (bf16_t*)(ws + SLOT(3)), (float*)(ws + SM_SSQ2)};
        pg8::gemm_phase(lds, g, S, E, wv);
    } SEAM(10);
    if (IN(11)) {
        pg8::Gemm g{(const bf16_t*)(ws + SLOT(3)), (const bf16_t*)(ws + W_UP), 1024, 1024, 1024}; pg8::TileOrder S; S.init(UP_MT, DFF / 128, G, c, 1024, 1024, UP_STRIDE, -2);
        EpiUp E{(const float*)(ws + SM_SSQ2), p.conv_w, p.conv_b, (bf16_t*)(ws + SLOT(4)), (LAS float*)(lds + LDS_HALO)};
        pg8::gemm_phase(lds, g, S, E, wv);
    } SEAM(11);
    constexpr int R_TAIL = (BATCH - 1) * SEQ + (256 * 256 - (BATCH - 1) * LTOK - NMETA);
    if (IN(12)) {
        pg8::Gemm g{(const bf16_t*)(ws + SLOT(4)), (const bf16_t*)(ws + W_DN), DFF, DFF, DFF}; pg8::TileOrder S; S.init(256, 4, G, c, DFF, DFF);
        EpiDown E{(const bf16_t*)(ws + SLOT(3)), (bf16_t*)(ws + SLOT(0)), (float*)(ws + SM_SSQ3), 0};
        pg8::gemm_phase(lds, g, S, E, wv);
    } SEAM(12);
    if (IN(13)) {
        if (G > 16 && c < 8) {
            pg8::Gemm g{(const bf16_t*)(ws + SLOT(4)), (const bf16_t*)(ws + W_DN), DFF, DFF, DFF}; pg8::TileOrder S; S.init(2, 4, 8, c, DFF, DFF, 256, 65536);
            EpiDown E{(const bf16_t*)(ws + SLOT(3)), (bf16_t*)(ws + SLOT(0)), (float*)(ws + SM_SSQ3), 256};
            pg8::gemm_phase(lds, g, S, E, wv);
        } else if (G > 16) { phase_final(p, wv, 0, R_TAIL, c - 8, G - 8); }
        else {
            pg8::Gemm g{(const bf16_t*)(ws + SLOT(4)), (const bf16_t*)(ws + W_DN), DFF, DFF, DFF}; pg8::TileOrder S; S.init(2, 4, G, c, DFF, DFF, 256, 65536);
            EpiDown E{(const bf16_t*)(ws + SLOT(3)), (bf16_t*)(ws + SLOT(0)), (float*)(ws + SM_SSQ3), 256};
            pg8::gemm_phase(lds, g, S, E, wv);
        }
    } SEAM(13);
    if (IN(14)) { if (G > 16) phase_final(p, wv, R_TAIL, BATCH * SEQ, c, G); else phase_final(p, wv, 0, BATCH * SEQ, c, G); }
}

#ifndef DBG_STOP
#define DBG_STOP -1
#endif
#ifndef DBG_SLOT
#define DBG_SLOT 100
#endif
__global__ void dbg_copy_bf16(const bf16_t* src, float* out, size_t n) { for (size_t i = (size_t)blockIdx.x * blockDim.x + threadIdx.x; i < n; i += (size_t)gridDim.x * blockDim.x) out[i] = __uint_as_float((unsigned)src[i] << 16); }
__global__ void dbg_sum4(const bf16_t* a, const bf16_t* b, const bf16_t* c, const float* d, float* out, size_t n) { for (size_t i = (size_t)blockIdx.x * blockDim.x + threadIdx.x; i < n; i += (size_t)gridDim.x * blockDim.x) out[i] = __uint_as_float((unsigned)a[i] << 16) + __uint_as_float((unsigned)b[i] << 16) + __uint_as_float((unsigned)c[i] << 16) + d[i % ((size_t)NCH * 1024)]; }
__global__ void dbg_copy_f32(const float* src, float* out, size_t n) { for (size_t i = (size_t)blockIdx.x * blockDim.x + threadIdx.x; i < n; i += (size_t)gridDim.x * blockDim.x) out[i] = src[i]; }
extern "C" void kernel_launch(void* const* d_in, const int* in_sizes, int n_in, void* d_out, int out_size, void* d_ws, size_t ws_size, hipStream_t stream) {
    static int grid = 0;
    if (grid == 0) {
        if (n_in != 24 || ws_size < WS_NEED || out_size != BATCH * SEQ * D) { fprintf(stderr, "kernel_launch: unexpected shapes (n_in %d, ws %zu need %zu, out %d)\n", n_in, ws_size, (size_t)WS_NEED, out_size); grid = -1; return; }
        int dev = 0, cus = 0, per_cu = 0;
        (void)hipGetDevice(&dev); (void)hipDeviceGetAttribute(&cus, hipDeviceAttributeMultiprocessorCount, dev);
        if (hipFuncSetAttribute((const void*)mk_fwd, hipFuncAttributeMaxDynamicSharedMemorySize, LDS_BYTES) != hipSuccess) { fprintf(stderr, "kernel_launch: hipFuncSetAttribute failed\n"); grid = -1; return; }
        if (hipOccupancyMaxActiveBlocksPerMultiprocessor(&per_cu, (const void*)mk_fwd, 512, LDS_BYTES) != hipSuccess || per_cu < 1) { fprintf(stderr, "kernel_launch: occupancy query says %d\n", per_cu); per_cu = 1; }
        (void)hipGetLastError();
        grid = cus * 1;
    }
    if (grid < 0) return;
    Params p{};
    const float** pp = (const float**)&p;
    for (int i = 0; i < 24; ++i) pp[i] = (const float*)d_in[i];
    p.out = (float*)d_out; p.ws = (unsigned char*)d_ws;
#if MK_PER_PHASE
    for (int ph = 0; ph < N_PHASES; ++ph) { if (DBG_STOP >= 0 && ph > DBG_STOP) break; p.ph_lo = ph; p.ph_hi = ph + 1; hipLaunchKernelGGL(mk_fwd, dim3(grid), dim3(512), LDS_BYTES, stream, p); }
    if (DBG_STOP >= 0) {
        const size_t n = (size_t)BATCH * SEQ * D;
        if (DBG_SLOT == 100) { hipMemcpyAsync((char*)d_ws + SLOT(2), d_out, n * 2, hipMemcpyDeviceToDevice, stream); hipLaunchKernelGGL(dbg_copy_bf16, dim3(2048), dim3(256), 0, stream, (const bf16_t*)((char*)d_ws + SLOT(2)), (float*)d_out, n); }
        else if (DBG_SLOT == 150) hipLaunchKernelGGL(dbg_sum4, dim3(2048), dim3(256), 0, stream, (const bf16_t*)((char*)d_ws + SLOT(4)), (const bf16_t*)((char*)d_ws + SLOT(5)), (const bf16_t*)((char*)d_ws + SLOT(6)), (const float*)((char*)d_ws + SM_DEC), (float*)d_out, n);
        else if (DBG_SLOT >= 200) hipLaunchKernelGGL(dbg_copy_f32, dim3(2048), dim3(256), 0, stream, (const float*)((char*)d_ws + SLOT(DBG_SLOT - 200)), (float*)d_out, n);
        else hipLaunchKernelGGL(dbg_copy_bf16, dim3(2048), dim3(256), 0, stream, (const bf16_t*)((char*)d_ws + SLOT(DBG_SLOT)), (float*)d_out, n);
    }
#else
    p.ph_lo = 0; p.ph_hi = N_PHASES;
    (void)hipMemsetAsync((char*)d_ws + CTL_OFF, 0, 256, stream);
    void* args[] = {&p};
    hipError_t e = hipLaunchCooperativeKernel((const void*)mk_fwd, dim3(grid), dim3(512), args, LDS_BYTES, stream);
    if (e != hipSuccess) fprintf(stderr, "cooperative launch failed: %s (grid %d)\n", hipGetErrorString(e), grid);
#endif
}
```

```cpp
#include <hip/hip_runtime.h>
#include <hip/hip_cooperative_groups.h>
#include <cstdio>
#include <cstdint>
namespace cg = cooperative_groups;

#ifndef MK_PER_PHASE
#define MK_PER_PHASE 0
#endif

#define LAS __attribute__((address_space(3)))
typedef unsigned short bf16_t;
typedef short bf16x8 __attribute__((ext_vector_type(8)));
typedef short bf16x4 __attribute__((ext_vector_type(4)));
typedef float f32x4 __attribute__((ext_vector_type(4)));
typedef float f32x2 __attribute__((ext_vector_type(2)));
typedef unsigned u32x4 __attribute__((ext_vector_type(4)));
typedef unsigned u32x2 __attribute__((ext_vector_type(2)));

constexpr int D = 1024, BATCH = 32, SEQ = 2048, NMETA = 16, LTOK = SEQ + NMETA, M = BATCH * LTOK;
constexpr int CPB = LTOK / 16, NCH = M / 16;
constexpr int DFF = 2816, NUP = 2 * DFF;
constexpr int NIN = 7168, NG1A = 5120, NG1B = 2048;
constexpr int S5_MT = 16;
constexpr int XS_LD = 384;
constexpr float EPS = 1e-6f;
constexpr int UP_MT = 261, UP_STRIDE = 254;

constexpr size_t UB = (size_t)M * 1024 * 2;
constexpr size_t W_WIN = 0;
constexpr size_t W_GLU = W_WIN + (size_t)NIN * 1024 * 2;
constexpr size_t W_A = W_GLU + 2097152, W_B = W_A + 2097152, W_O = W_B + 2097152;
constexpr size_t W_UP = W_O + 2097152;
constexpr size_t W_DN = W_UP + (size_t)NUP * 1024 * 2;
constexpr size_t W_KE = W_DN + (size_t)1024 * DFF * 2;
constexpr size_t W_W5 = W_KE + (size_t)64 * 256 * 384 * 2;
constexpr size_t W_END = W_W5 + (size_t)64 * 256 * 256 * 2;
constexpr size_t SLOT0 = 64u << 20;
constexpr size_t CTL_OFF = SLOT0 - 4096;
static_assert(W_END <= CTL_OFF, "weights region");
#define SLOT(i) (SLOT0 + (size_t)(i) * UB)
constexpr size_t SM0 = SLOT0 + 7 * UB;
constexpr size_t SM_RS1 = SM0;
constexpr size_t SM_SSQ2 = SM_RS1 + (size_t)M * 4;
constexpr size_t SM_SSQ3 = SM_SSQ2 + (size_t)M * 64;
constexpr size_t SM_DEC = SM_SSQ3 + (size_t)M * 64;
constexpr size_t SM_A16 = SM_DEC + (size_t)NCH * 4096;
constexpr size_t WS_NEED = SM_A16 + 64 * 64 * 8;

__device__ __forceinline__ unsigned cvt_pk_bf16(float lo, float hi) { unsigned r; asm volatile("s_nop 1\n\tv_cvt_pk_bf16_f32 %0, %1, %2" : "=v"(r) : "v"(lo), "v"(hi)); return r; }
__device__ __forceinline__ float bf_lo(unsigned w) { return __uint_as_float(w << 16); }
__device__ __forceinline__ float bf_hi(unsigned w) { return __uint_as_float(w & 0xffff0000u); }
__device__ __forceinline__ float sigm(float x) { return __builtin_amdgcn_rcpf(1.f + __expf(-x)); }
__device__ __forceinline__ float gelu_tanh(float x) { const float z = 1.5957691216f * (x + 0.044715f * x * x * x); return x * sigm(z); }
__device__ __forceinline__ int lane_id_v() { int l; asm volatile("v_mbcnt_lo_u32_b32 %0, -1, 0\n\tv_mbcnt_hi_u32_b32 %0, -1, %0" : "=v"(l)); return l; }
template <int CTRL> __device__ __forceinline__ float dpp_f1(float x) { return __int_as_float(__builtin_amdgcn_update_dpp(0x3f800000, __float_as_int(x), CTRL, 0xF, 0xF, false)); }
template <int CTRL> __device__ __forceinline__ float dpp_fo(float old, float x) { return __int_as_float(__builtin_amdgcn_update_dpp(__float_as_int(old), __float_as_int(x), CTRL, 0xF, 0xF, false)); }
__device__ __forceinline__ float xsum_rows(float x) {
    const u32x2 a = __builtin_amdgcn_permlane16_swap(__float_as_uint(x), __float_as_uint(x), false, false);
    x = __uint_as_float(a[0]) + __uint_as_float(a[1]);
    const u32x2 b = __builtin_amdgcn_permlane32_swap(__float_as_uint(x), __float_as_uint(x), false, false);
    return __uint_as_float(b[0]) + __uint_as_float(b[1]);
}
template <int CTRL> __device__ __forceinline__ float dpp_f(float x) { return __int_as_float(__builtin_amdgcn_update_dpp(0, __float_as_int(x), CTRL, 0xF, 0xF, true)); }
__device__ __forceinline__ float wave_sum(float v) {
#pragma unroll
    for (int o = 1; o < 64; o <<= 1) v += __shfl_xor(v, o);
    return v;
}
__device__ __forceinline__ void unpack8(const u32x4 w, float (&v)[8]) {
    v[0] = bf_lo(w.x); v[1] = bf_hi(w.x); v[2] = bf_lo(w.y); v[3] = bf_hi(w.y); v[4] = bf_lo(w.z); v[5] = bf_hi(w.z); v[6] = bf_lo(w.w); v[7] = bf_hi(w.w);
}
__device__ __forceinline__ u32x4 pack8(const f32x4 a, const f32x4 b) {
    u32x4 w; w.x = cvt_pk_bf16(a[0], a[1]); w.y = cvt_pk_bf16(a[2], a[3]); w.z = cvt_pk_bf16(b[0], b[1]); w.w = cvt_pk_bf16(b[2], b[3]); return w;
}

namespace pg8 {
constexpr int BM = 256, BK = 64, HALF = 128, HTB = HALF * BK * 2, STAGE_BYTES = 8 * HTB, NXCD = 8, WGM = 8;
__host__ __device__ __forceinline__ int lds_byte(int r, int c) { const int st = (r >> 4) * 2 + (c >> 5), rr = r & 15, cc = c & 31, ob = rr * 64 + cc * 2; return st * 1024 + (ob ^ (((ob >> 9) & 1) << 5)); }
__host__ __device__ __forceinline__ void stage_rc(int b, int& R, int& C) { const int st = b / 1024, sb = b % 1024, swz = sb ^ (((sb >> 9) & 1) << 5); R = (st >> 1) * 16 + swz / 64; C = (st & 1) * 32 + (swz % 64) / 2; }
__host__ __device__ __forceinline__ int perm32(int rho) { const int n = rho >> 4, i = rho & 15; return 8 * (i >> 2) + 4 * n + (i & 3); }

struct Unit { int pm, pn; long offA, offB; };
struct Gemm { const bf16_t* A; const bf16_t* Bt; int K, lda, ldb; int a_hrows = 128; };

struct TileOrder {
    int nM, nN, nwg, G, c, a_stride, a_row0, lda, ldb, split_pn; long a2_off, b2_off;
    __device__ void init(int nM_, int nN_, int G_, int c_, int lda_, int ldb_, int a_stride_ = 256, int a_row0_ = 0) { nM = nM_; nN = nN_; nwg = nM * nN; G = G_; c = c_; lda = lda_; ldb = ldb_; a_stride = a_stride_; a_row0 = a_row0_; split_pn = 1 << 30; a2_off = 0; b2_off = 0; }
    __device__ bool next(int i, Unit& u) const {
        const long L = (long)i * G + c; if (L >= nwg) return false;
        int wgid = (int)L; { const int q = nwg / NXCD, r = nwg % NXCD, xcd = wgid % NXCD, off = wgid / NXCD; wgid = (xcd < r ? xcd * (q + 1) : r * (q + 1) + (xcd - r) * q) + off; }
        const int nig = WGM * nN, gid = wgid / nig, fm = gid * WGM, gsz = (nM - fm) < WGM ? (nM - fm) : WGM;
        u.pm = fm + ((wgid % nig) % gsz); u.pn = (wgid % nig) / gsz;
        u.offA = ((long)u.pm * a_stride + a_row0) * lda * 2; u.offB = (long)u.pn * 256 * ldb * 2;
        if (u.pn >= split_pn) { u.offA += a2_off; u.offB = b2_off + (long)(u.pn - split_pn) * 256 * ldb * 2; }
        return true;
    }
};
struct GroupOrder {
    int G, c, ldb, row0;
    __device__ void init(int G_, int c_, int ldb_, int row0_) { G = G_; c = c_; ldb = ldb_; row0 = row0_; }
    __device__ bool next(int i, Unit& u) const {
        const unsigned L = (unsigned)(i * G + c); if (L >= 64u * S5_MT) return false;
        const unsigned q = L >> 5, j = (L >> 3) & 3u, x = L & 7u, sg = q * 8u + x, g4 = sg / (unsigned)S5_MT;
        u.pn = (int)(4u * g4 + j); u.pm = (int)(sg - g4 * (unsigned)S5_MT);
        u.offA = ((long)u.pn * NCH + (long)u.pm * 2 * CPB + row0) * XS_LD * 2; u.offB = (long)u.pn * 256 * ldb * 2; return true;
    }
};

template <class Epi, class Sched>
__device__ __forceinline__ void gemm_phase(LAS unsigned char* lds, const Gemm g, const Sched& S, const Epi& E, const int wv) {
    const int tid = wv * 64 + lane_id_v();
    const int wid = __builtin_amdgcn_readfirstlane(tid >> 6), lane = tid & 63, wr = wid >> 2, wc = wid & 3, fr = lane & 15, fq = lane >> 4;
    const int K = g.K, nt = K / BK;
    unsigned voffA[2], voffB[2];
#pragma unroll
    for (int i = 0; i < 2; ++i) { int R, C; stage_rc(tid * 16 + i * 8192, R, C); const int Rb = (R & ~31) + perm32(R & 31);
        voffA[i] = (unsigned)(R * g.lda + C) * 2u; voffB[i] = (unsigned)(Rb * g.ldb + C) * 2u; }
    const size_t kstep = (size_t)(BK * 2);
    const size_t hstepA = (size_t)g.a_hrows * g.lda * 2, hstepB = (size_t)HALF * g.ldb * 2;
    const unsigned ldsw = (unsigned)wid * 1024u;
    const int aoff = lds_byte(wr * 64 + fr, fq * 8), boff = lds_byte(wc * 32 + fr, fq * 8);
#define PG8_SA(b, h) (((b) * 2 + (h)) * HTB)
#define PG8_SB(b, h) ((4 + (b) * 2 + (h)) * HTB)
#define PG8_STAGE(bufoff, gbase, voff) do { _Pragma("unroll") for (int _i = 0; _i < 2; ++_i) \
        __builtin_amdgcn_global_load_lds((const unsigned*)((const char*)(gbase) + (voff)[_i]), (LAS unsigned*)(lds + (bufoff) + ldsw + _i * 8192), 16, 0, 0); } while (0)
#define PG8_LDA(dst, b, h) do { _Pragma("unroll") for (int m = 0; m < 4; ++m) _Pragma("unroll") for (int k = 0; k < 2; ++k) dst[m][k] = *(const LAS bf16x8*)(lds + PG8_SA(b, h) + aoff + m * 2048 + k * 1024); } while (0)
#define PG8_LDB(dst, b, h) do { _Pragma("unroll") for (int n = 0; n < 2; ++n) _Pragma("unroll") for (int k = 0; k < 2; ++k) dst[n][k] = *(const LAS bf16x8*)(lds + PG8_SB(b, h) + boff + n * 2048 + k * 1024); } while (0)
#define PG8_MMA(ai, bj, At, Bt) do { __builtin_amdgcn_s_setprio(1); _Pragma("unroll") for (int m = 0; m < 4; ++m) _Pragma("unroll") for (int n = 0; n < 2; ++n) _Pragma("unroll") for (int k = 0; k < 2; ++k) \
        acc[ai][bj][m][n] = __builtin_amdgcn_mfma_f32_16x16x32_bf16(Bt[n][k], At[m][k], acc[ai][bj][m][n], 0, 0, 0); __builtin_amdgcn_s_setprio(0); } while (0)
#define PG8_WAIT_V(n) asm volatile("s_waitcnt vmcnt(" #n ")" ::: "memory")
#define PG8_WAIT_L(n) asm volatile("s_waitcnt lgkmcnt(" #n ")" ::: "memory")
#define PG8_BAR __builtin_amdgcn_s_barrier()
#define PG8_SCHED __builtin_amdgcn_sched_barrier(0)
    Unit cur, nxt; int ui = 0;
    if (!S.next(0, cur)) return;
    f32x4 acc[2][2][4][2];
#pragma unroll
    for (int a = 0; a < 2; ++a)
#pragma unroll
        for (int b = 0; b < 2; ++b)
#pragma unroll
            for (int m = 0; m < 4; ++m)
#pragma unroll
                for (int n = 0; n < 2; ++n) acc[a][b][m][n] = (f32x4){0.f, 0.f, 0.f, 0.f};
    bf16x8 At[4][2], B0[2][2], B1[2][2];
    const char* cA = (const char*)g.A + cur.offA; const char* cB = (const char*)g.Bt + cur.offB;
    PG8_STAGE(PG8_SB(0, 0), cB, voffB); PG8_STAGE(PG8_SB(0, 1), cB + hstepB, voffB); PG8_STAGE(PG8_SA(0, 0), cA, voffA); PG8_STAGE(PG8_SA(0, 1), cA + hstepA, voffA);
    if (wr == 1) PG8_BAR;
    PG8_WAIT_V(2); PG8_BAR;
    PG8_STAGE(PG8_SB(1, 0), cB + kstep, voffB); PG8_STAGE(PG8_SA(1, 0), cA + kstep, voffA); PG8_STAGE(PG8_SB(1, 1), cB + hstepB + kstep, voffB);
    PG8_WAIT_V(6); PG8_BAR;
    for (;;) {
        const bool has_next = S.next(ui + 1, nxt);
        const char* nA = has_next ? (const char*)g.A + nxt.offA : cA; const char* nB = has_next ? (const char*)g.Bt + nxt.offB : cB;
#pragma unroll 1
        for (int t = 0; t < nt; t += 2) {
            const bool last = (t == nt - 2);
            const char* a1 = cA + (size_t)(t + 1) * kstep;
            const char* a2 = last ? nA : cA + (size_t)(t + 2) * kstep; const char* b2 = last ? nB : cB + (size_t)(t + 2) * kstep;
            const char* a3 = a2 + kstep; const char* b3 = b2 + kstep;
            PG8_LDB(B0, 0, 0); PG8_LDB(B1, 0, 1); PG8_SCHED; PG8_LDA(At, 0, 0); PG8_STAGE(PG8_SA(1, 1), a1 + hstepA, voffA);
            PG8_WAIT_V(8); PG8_WAIT_L(0); PG8_BAR; PG8_MMA(0, 0, At, B0); PG8_MMA(0, 1, At, B1); PG8_BAR; PG8_SCHED;
            PG8_LDA(At, 0, 1); PG8_STAGE(PG8_SB(0, 0), b2, voffB); PG8_STAGE(PG8_SB(0, 1), b2 + hstepB, voffB); PG8_STAGE(PG8_SA(0, 0), a2, voffA);
            PG8_WAIT_V(8); PG8_WAIT_L(0); PG8_BAR; PG8_MMA(1, 0, At, B0); PG8_MMA(1, 1, At, B1); PG8_BAR; PG8_SCHED;
            PG8_LDB(B0, 1, 0); PG8_LDB(B1, 1, 1); PG8_SCHED; PG8_LDA(At, 1, 0); PG8_STAGE(PG8_SA(0, 1), a2 + hstepA, voffA);
            PG8_WAIT_V(8); PG8_WAIT_L(0); PG8_BAR; PG8_MMA(0, 0, At, B0); PG8_MMA(0, 1, At, B1); PG8_BAR; PG8_SCHED;
            PG8_LDA(At, 1, 1); PG8_STAGE(PG8_SB(1, 0), b3, voffB); PG8_STAGE(PG8_SB(1, 1), b3 + hstepB, voffB); PG8_STAGE(PG8_SA(1, 0), a3, voffA);
            PG8_WAIT_V(8); PG8_WAIT_L(0); PG8_BAR; PG8_MMA(1, 0, At, B0); PG8_MMA(1, 1, At, B1); PG8_BAR; PG8_SCHED;
        }
        if (wr == 0) PG8_BAR;
        { const int l2 = lane_id_v(); E(acc, cur, wr, wc, l2 & 15, (l2 >> 4) & 3); }
        if (!has_next) break;
#pragma unroll
        for (int a = 0; a < 2; ++a)
#pragma unroll
            for (int b = 0; b < 2; ++b)
#pragma unroll
                for (int m = 0; m < 4; ++m)
#pragma unroll
                    for (int n = 0; n < 2; ++n) acc[a][b][m][n] = (f32x4){0.f, 0.f, 0.f, 0.f};
        cur = nxt; cA = nA; cB = nB; ++ui;
        if (wr == 1) PG8_BAR;
    }
    PG8_WAIT_V(0);
    PG8_BAR;
#undef PG8_SA
#undef PG8_SB
#undef PG8_STAGE
#undef PG8_LDA
#undef PG8_LDB
#undef PG8_MMA
#undef PG8_WAIT_V
#undef PG8_WAIT_L
#undef PG8_BAR
#undef PG8_SCHED
}
}
using pg8::Unit;
typedef f32x4 Acc[2][2][4][2];

#define FOR_AI_M _Pragma("unroll") for (int ai = 0; ai < 2; ++ai) _Pragma("unroll") for (int m = 0; m < 4; ++m)
#define FOR_BJ _Pragma("unroll") for (int bj = 0; bj < 2; ++bj)

struct EpiG1a {
    bf16_t* xs5; bf16_t* qi; bf16_t* ki; bf16_t* vb; bf16_t* ogb; float* dec; const float* rs1; const float* lbl;
    __device__ __forceinline__ void operator()(Acc& acc, const Unit& u, int wr, int wc, int fr, int fq) const {
        const int row0 = u.pm * 256 + wr * 64 + fr;
        float rsa[2][4];
        FOR_AI_M rsa[ai][m] = rs1[row0 + ai * 128 + m * 16];
        if (u.pn >= 4 && u.pn < 12) {
            const int hh = u.pn - 4, d0 = hh * 128 + wc * 32 + fq * 8;
            float lb[8];
#pragma unroll
            for (int i = 0; i < 8; ++i) lb[i] = sigm(lbl[d0 + i] - lbl[1024 + d0 + i]);
            FOR_AI_M {
                const int row = row0 + ai * 128 + m * 16; const float rs = rsa[ai][m];
                f32x4 oq[2], ok[2], od[2];
#pragma unroll
                for (int n = 0; n < 2; ++n)
#pragma unroll
                    for (int j = 0; j < 4; ++j) {
                        const float q = rs * acc[ai][0][m][n][j]; const float v = rs * acc[ai][1][m][n][j];
                        const float l = lb[n * 4 + j], e = __expf(-v), sg = __builtin_amdgcn_rcpf(1.f + e);
                        const float f = l + (1.f - l) * sg, kk = (1.f - l) * (1.f - sg);
                        float e1 = f;
                        e1 *= dpp_f1<0x111>(e1); e1 *= dpp_f1<0x112>(e1); e1 *= dpp_f1<0x114>(e1); e1 *= dpp_f1<0x118>(e1);
                        oq[n][j] = q * e1; ok[n][j] = kk * __builtin_amdgcn_rcpf(e1); od[n][j] = e1;
                    }
                *(u32x4*)(qi + (size_t)row * 1024 + d0) = pack8(oq[0], oq[1]);
                *(u32x4*)(ki + (size_t)row * 1024 + d0) = pack8(ok[0], ok[1]);
                if (fr == 15) { float* dp = dec + (size_t)(row >> 4) * 1024 + d0; *(f32x4*)dp = od[0]; *(f32x4*)(dp + 4) = od[1]; }
            }
        } else if (u.pn < 4) {
            FOR_AI_M {
                const int row = row0 + ai * 128 + m * 16; const float rs = rsa[ai][m];
                const int n_ch = row >> 4, t = row & 15;
                FOR_BJ {
                    const int g = u.pn * 16 + bj * 8 + wc * 2 + (fq >> 1), h0 = (fq & 1) * 8;
                    *(u32x4*)(xs5 + ((size_t)g * NCH + n_ch) * XS_LD + t * 16 + h0) = pack8(acc[ai][bj][m][0] * rs, acc[ai][bj][m][1] * rs);
                }
            }
        } else {
            bf16_t* dst = (u.pn < 16) ? vb : ogb; const int c0 = ((u.pn - 12) & 3) * 256 + wc * 32 + fq * 8;
            FOR_AI_M {
                const int row = row0 + ai * 128 + m * 16; const float rs = rsa[ai][m];
                FOR_BJ *(u32x4*)(dst + (size_t)row * 1024 + c0 + bj * 128) = pack8(acc[ai][bj][m][0] * rs, acc[ai][bj][m][1] * rs);
            }
        }
    }
};
struct EpiS5i {
    bf16_t* L;
    __device__ __forceinline__ void operator()(Acc& acc, const Unit& u, int wr, int wc, int fr, int fq) const {
        FOR_AI_M {
            const int ch = (2 * u.pm + ai) * CPB + wr * 64 + m * 16 + fr;
            *(u32x4*)(L + ((size_t)u.pn * NCH + ch) * 128 + wc * 32 + fq * 8) = pack8(acc[ai][0][m][0], acc[ai][0][m][1]);
        }
    }
};
struct EpiS5y {
    const bf16_t* xs5; const float* dsk; bf16_t* y;
    __device__ __forceinline__ void operator()(Acc& acc, const Unit& u, int wr, int wc, int fr, int fq) const {
        const int g = u.pn, h0 = (fq & 1) * 8;
        const f32x4 dva = *(const f32x4*)(dsk + g * 16 + h0), dvb = *(const f32x4*)(dsk + g * 16 + h0 + 4);
        const float dv[8] = {dva[0], dva[1], dva[2], dva[3], dvb[0], dvb[1], dvb[2], dvb[3]};
#pragma unroll
        for (int ai = 0; ai < 2; ++ai) {
            u32x4 uw[4][2];
#pragma unroll
            for (int m = 0; m < 4; ++m) {
                const int ch = (2 * u.pm + ai) * CPB + 1 + wr * 64 + m * 16 + fr;
#pragma unroll
                for (int bj = 0; bj < 2; ++bj) { const int t = bj * 8 + wc * 2 + (fq >> 1); uw[m][bj] = *(const u32x4*)(xs5 + ((size_t)g * NCH + ch) * XS_LD + t * 16 + h0); }
            }
#pragma unroll
            for (int m = 0; m < 4; ++m) {
                const int ch = (2 * u.pm + ai) * CPB + 1 + wr * 64 + m * 16 + fr;
#pragma unroll
                for (int bj = 0; bj < 2; ++bj) {
                    const int t = bj * 8 + wc * 2 + (fq >> 1);
                    float uv[8]; unpack8(uw[m][bj], uv);
                    f32x4 o0, o1;
#pragma unroll
                    for (int j = 0; j < 4; ++j) { o0[j] = gelu_tanh(acc[ai][bj][m][0][j] + dv[j] * uv[j]); o1[j] = gelu_tanh(acc[ai][bj][m][1][j] + dv[4 + j] * uv[4 + j]); }
                    *(u32x4*)(y + ((size_t)ch * 16 + t) * 1024 + g * 16 + h0) = pack8(o0, o1);
                }
            }
        }
    }
};
template <int MODE> struct EpiRow {
    const bf16_t* in; bf16_t* out; const float* rs1;
    __device__ __forceinline__ void operator()(Acc& acc, const Unit& u, int wr, int wc, int fr, int fq) const {
        const int row0 = u.pm * 256 + wr * 64 + fr, c0 = (u.pn & 3) * 256 + wc * 32 + fq * 8;
        bf16_t* o = out + (MODE == 1 ? (size_t)(u.pn >> 2) * (UB / 2) : 0);
        u32x4 vin[2][2][2], win[2][2][2]; float rsv[2][2];
#define EPIROW_LOAD(B) do { const int ai_ = (B) >> 1, mp_ = (B) & 1; _Pragma("unroll") for (int mm = 0; mm < 2; ++mm) { const int row = row0 + ai_ * 128 + (mp_ * 2 + mm) * 16; \
            if (MODE == 1) rsv[(B) & 1][mm] = rs1[row]; \
            _Pragma("unroll") for (int bj = 0; bj < 2; ++bj) { const size_t off = (size_t)row * 1024 + c0 + bj * 128; \
                if (MODE == 0 || MODE == 2 || MODE == 3) vin[(B) & 1][mm][bj] = *(const u32x4*)(in + off); \
                if (MODE == 3) win[(B) & 1][mm][bj] = *(const u32x4*)(o + off); } } } while (0)
        EPIROW_LOAD(0);
#pragma unroll
        for (int b = 0; b < 4; ++b) {
            if (b + 1 < 4) EPIROW_LOAD(b + 1);
            const int ai = b >> 1, mp = b & 1;
#pragma unroll
            for (int mm = 0; mm < 2; ++mm) {
                const int m = mp * 2 + mm; const int row = row0 + ai * 128 + m * 16;
#pragma unroll
                for (int bj = 0; bj < 2; ++bj) {
                    const size_t off = (size_t)row * 1024 + c0 + bj * 128;
                    f32x4 a0 = acc[ai][bj][m][0], a1 = acc[ai][bj][m][1];
                    if (MODE == 0) { float v[8]; unpack8(vin[b & 1][mm][bj], v);
#pragma unroll
                        for (int j = 0; j < 4; ++j) { a0[j] = v[j] * sigm(a0[j]); a1[j] = v[4 + j] * sigm(a1[j]); } }
                    if (MODE == 1) { const float rs = rsv[b & 1][mm];
#pragma unroll
                        for (int j = 0; j < 4; ++j) { a0[j] = sigm(rs * a0[j]); a1[j] = sigm(rs * a1[j]); } }
                    if (MODE == 2) { float v[8]; unpack8(vin[b & 1][mm][bj], v);
#pragma unroll
                        for (int j = 0; j < 4; ++j) { a0[j] = v[j] * a0[j]; a1[j] = v[4 + j] * a1[j]; } }
                    if (MODE == 3) { float v[8], w[8]; unpack8(vin[b & 1][mm][bj], v); unpack8(win[b & 1][mm][bj], w);
#pragma unroll
                        for (int j = 0; j < 4; ++j) { a0[j] = w[j] + v[j] * a0[j]; a1[j] = w[4 + j] + v[4 + j] * a1[j]; } }
                    *(u32x4*)(o + off) = pack8(a0, a1);
                }
            }
        }
#undef EPIROW_LOAD
    }
};
struct EpiGluGates {
    EpiRow<0> e0; EpiRow<1> e1;
    __device__ __forceinline__ void operator()(Acc& acc, const Unit& u, int wr, int wc, int fr, int fq) const {
        if (u.pn < 4) e0(acc, u, wr, wc, fr, fq); else { Unit u2 = u; u2.pn -= 4; e1(acc, u2, wr, wc, fr, fq); }
    }
};
struct EpiOut {
    const float* x; const float* meta; bf16_t* h2b; float* ssq;
    __device__ __forceinline__ void operator()(Acc& acc, const Unit& u, int wr, int wc, int fr, int fq) const {
        const int row0 = u.pm * 256 + wr * 64 + fr, c0 = u.pn * 256 + wc * 32 + fq * 8;
#pragma unroll
        for (int ai = 0; ai < 2; ++ai)
#pragma unroll
            for (int mp = 0; mp < 2; ++mp) {
                f32x4 hv[2][2][2];
#pragma unroll
                for (int mm = 0; mm < 2; ++mm) {
                    const int row = row0 + ai * 128 + (mp * 2 + mm) * 16; const int b = row / LTOK, t = row - b * LTOK;
                    const float* hp = (t < NMETA) ? meta + (size_t)t * 1024 : x + ((size_t)b * SEQ + (t - NMETA)) * 1024;
#pragma unroll
                    for (int bj = 0; bj < 2; ++bj) { hv[mm][bj][0] = *(const f32x4*)(hp + c0 + bj * 128); hv[mm][bj][1] = *(const f32x4*)(hp + c0 + bj * 128 + 4); }
                }
#pragma unroll
                for (int mm = 0; mm < 2; ++mm) {
                    const int m = mp * 2 + mm; const int row = row0 + ai * 128 + m * 16;
                    float ss = 0.f;
#pragma unroll
                    for (int bj = 0; bj < 2; ++bj) {
                        const int c = c0 + bj * 128;
                        const f32x4 a0 = acc[ai][bj][m][0] + hv[mm][bj][0], a1 = acc[ai][bj][m][1] + hv[mm][bj][1];
                        *(u32x4*)(h2b + (size_t)row * 1024 + c) = pack8(a0, a1);
#pragma unroll
                        for (int j = 0; j < 4; ++j) ss += a0[j] * a0[j] + a1[j] * a1[j];
                    }
                    ss = xsum_rows(ss);
                    if (fq == 0) ssq[(size_t)row * 16 + u.pn * 4 + wc] = ss;
                }
            }
    }
};
struct EpiDown {
    const bf16_t* h2b; bf16_t* h3b; float* ssq; int pm_off;
    __device__ __forceinline__ void operator()(Acc& acc, const Unit& u, int wr, int wc, int fr, int fq) const {
        const int row0 = (u.pm + pm_off) * 256 + wr * 64 + fr, c0 = u.pn * 256 + wc * 32 + fq * 8;
#pragma unroll
        for (int ai = 0; ai < 2; ++ai)
#pragma unroll
            for (int mp = 0; mp < 2; ++mp) {
                u32x4 hv[2][2];
#pragma unroll
                for (int mm = 0; mm < 2; ++mm) {
                    const int row = row0 + ai * 128 + (mp * 2 + mm) * 16;
#pragma unroll
                    for (int bj = 0; bj < 2; ++bj) hv[mm][bj] = *(const u32x4*)(h2b + (size_t)row * 1024 + c0 + bj * 128);
                }
#pragma unroll
                for (int mm = 0; mm < 2; ++mm) {
                    const int m = mp * 2 + mm; const int row = row0 + ai * 128 + m * 16; float ss = 0.f;
#pragma unroll
                    for (int bj = 0; bj < 2; ++bj) {
                        float rv[8]; unpack8(hv[mm][bj], rv); const f32x4 a0 = acc[ai][bj][m][0] + (f32x4){rv[0], rv[1], rv[2], rv[3]}, a1 = acc[ai][bj][m][1] + (f32x4){rv[4], rv[5], rv[6], rv[7]};
                        *(u32x4*)(h3b + (size_t)row * 1024 + c0 + bj * 128) = pack8(a0, a1);
#pragma unroll
                        for (int j = 0; j < 4; ++j) ss += a0[j] * a0[j] + a1[j] * a1[j];
                    }
                    ss = xsum_rows(ss);
                    if (fq == 0) ssq[(size_t)row * 16 + u.pn * 4 + wc] = ss;
                }
            }
    }
};
struct EpiUp {
    const float* ssq2; const float* cw; const float* cb; bf16_t* act; LAS float* halo;
    __device__ __forceinline__ void operator()(Acc& acc, const Unit& u, int wr, int wc, int fr, int fq) const {
        const int grow0 = u.pm * UP_STRIDE - 2 + wr * 64 + fr;
        {
            f32x4 sq[2][4];
            FOR_AI_M { const int grow = grow0 + ai * 128 + m * 16; const int gc = grow < 0 ? 0 : (grow >= M ? M - 1 : grow); sq[ai][m] = *(const f32x4*)(ssq2 + (size_t)gc * 16 + fq * 4); }
            FOR_AI_M {
                const int grow = grow0 + ai * 128 + m * 16;
                float sv = (sq[ai][m][0] + sq[ai][m][1]) + (sq[ai][m][2] + sq[ai][m][3]);
                sv = xsum_rows(sv);
                const float rs = (grow >= 0 && grow < M) ? __builtin_amdgcn_rsqf(sv * (1.f / 1024.f) + EPS) : 0.f;
                FOR_BJ { acc[ai][bj][m][0] *= rs; acc[ai][bj][m][1] *= rs; }
            }
        }
        const int cl = wc * 32 + fq * 8;
#pragma unroll
        for (int ai = 0; ai < 2; ++ai) { const int rg = 2 * ai + wr;
            if (rg <= 2 && fr >= 14) { FOR_BJ { LAS float* hp = halo + (rg * 2 + (fr - 14)) * 256 + bj * 128 + cl; *(LAS f32x4*)hp = acc[ai][bj][3][0]; *(LAS f32x4*)(hp + 4) = acc[ai][bj][3][1]; } } }
        f32x4 cwv[2][2][4];
#pragma unroll
        for (int bj = 0; bj < 2; ++bj)
#pragma unroll
            for (int n = 0; n < 2; ++n) { const int c = bj * DFF + u.pn * 128 + cl + n * 4; cwv[bj][n][0] = *(const f32x4*)(cw + c); cwv[bj][n][1] = *(const f32x4*)(cw + NUP + c); cwv[bj][n][2] = *(const f32x4*)(cw + 2 * NUP + c); cwv[bj][n][3] = *(const f32x4*)(cb + c); }
        asm volatile("s_waitcnt lgkmcnt(0)" ::: "memory"); __builtin_amdgcn_s_barrier(); asm volatile("" ::: "memory");
#ifndef UPTEST_NOCONV
        const int tfirst = u.pm * UP_STRIDE - 2, tmod = ((tfirst % LTOK) + LTOK) % LTOK; const bool has_start = (tmod <= 1) || (tmod + 255 >= LTOK);
        int tp[2][4];
        FOR_AI_M { const int grow = grow0 + ai * 128 + m * 16; tp[ai][m] = (has_start && grow >= 0) ? grow % LTOK : 2; }
#pragma unroll
        for (int bj = 0; bj < 2; ++bj)
#pragma unroll
            for (int n = 0; n < 2; ++n) {
                const f32x4 w0 = cwv[bj][n][0], w1 = cwv[bj][n][1], w2 = cwv[bj][n][2], bb = cwv[bj][n][3];
#pragma unroll
                for (int ai = 0; ai < 2; ++ai)
#pragma unroll
                    for (int mm = 0; mm < 4; ++mm) {
                        const int m = 3 - mm;
                        const f32x4 cur = acc[ai][bj][m][n]; f32x4 p1, p2, q1, q2;
                        if (m > 0) {
                            const f32x4 pv = acc[ai][bj][m - 1][n];
#pragma unroll
                            for (int j = 0; j < 4; ++j) { q1[j] = dpp_f<0x121>(pv[j]); q2[j] = dpp_f<0x122>(pv[j]); }
                        } else {
                            const int rg = 2 * ai + wr;
                            if (rg >= 1) { const LAS float* hp = halo + ((rg - 1) * 2) * 256 + bj * 128 + cl + n * 4; q1 = *(const LAS f32x4*)(hp + 256); q2 = *(const LAS f32x4*)(hp + (fr == 0 ? 0 : 256)); }
                            else { q1 = (f32x4){0.f, 0.f, 0.f, 0.f}; q2 = q1; }
                        }
#pragma unroll
                        for (int j = 0; j < 4; ++j) { p1[j] = dpp_fo<0x111>(q1[j], cur[j]); p2[j] = dpp_fo<0x112>(q2[j], cur[j]); }
                        if (has_start) {
                            const int t = tp[ai][m];
                            if (t < 1) p1 = (f32x4){0.f, 0.f, 0.f, 0.f};
                            if (t < 2) p2 = (f32x4){0.f, 0.f, 0.f, 0.f};
                        }
                        acc[ai][bj][m][n] = bb + w0 * p2 + w1 * p1 + w2 * cur;
                        asm volatile("" : "+v"(acc[ai][bj][m][n]));
                    }
            }
#endif
        FOR_AI_M {
            const int grow = grow0 + ai * 128 + m * 16; const int r = ai * 128 + wr * 64 + m * 16 + fr;
            if (r >= 2 && grow < M) {
                f32x4 o0, o1;
#pragma unroll
                for (int j = 0; j < 4; ++j) { const float a = acc[ai][0][m][0][j], b = acc[ai][0][m][1][j]; o0[j] = a * sigm(a) * acc[ai][1][m][0][j]; o1[j] = b * sigm(b) * acc[ai][1][m][1][j]; }
                *(u32x4*)(act + (size_t)grow * DFF + u.pn * 128 + cl) = pack8(o0, o1);
            }
        }
    }
};

struct Params {
    const float *x, *meta, *mix_g, *w_in, *lam_re, *lam_im, *log_dt, *b_re, *b_im, *c_re, *c_im, *ssm_d, *w_glu, *w_ssm, *lb_logits, *hg_norm, *w_hg, *w_out, *ffn_g, *w_up, *conv_w, *conv_b, *w_down, *fin_g;
    float* out; unsigned char* ws; int ph_lo, ph_hi;
};

__device__ __forceinline__ void transpose_item(const float* src, int N, int Kd, bf16_t* dst, int drow0, int scol0, int k0, const float* scale, LAS float* scr, int lane) {
    float tv[32];
#pragma unroll
    for (int i = 0; i < 32; ++i) { const int kk = 2 * i + (lane >> 5); tv[i] = src[(size_t)(k0 + kk) * N + scol0 + (lane & 31)]; }
#pragma unroll
    for (int i = 0; i < 32; ++i) { const int kk = 2 * i + (lane >> 5); float v = tv[i]; if (scale) v *= scale[k0 + kk]; scr[kk * 33 + (lane & 31)] = v; }
    asm volatile("s_waitcnt lgkmcnt(0)" ::: "memory");
    const int c = lane & 7;
#pragma unroll
    for (int j = 0; j < 4; ++j) { const int n = (lane >> 3) + 8 * j; const LAS float* s = scr + (8 * c) * 33 + n;
        u32x4 o; o.x = cvt_pk_bf16(s[0 * 33], s[1 * 33]); o.y = cvt_pk_bf16(s[2 * 33], s[3 * 33]); o.z = cvt_pk_bf16(s[4 * 33], s[5 * 33]); o.w = cvt_pk_bf16(s[6 * 33], s[7 * 33]);
        *(u32x4*)(dst + (size_t)(drow0 + n) * Kd + k0 + 8 * c) = o; }
    asm volatile("s_waitcnt lgkmcnt(0)" ::: "memory");
}
__device__ __forceinline__ void sincos_d(double a, float& s, float& c) {
    const double q = rint(a * 0.63661977236758134308);
    const double r = fma(-q, 1.57079632679489661923, a) - q * 6.12323399573676603587e-17;
    const double r2 = r * r;
    double sp = -7.6471637318198164759e-13; sp = fma(sp, r2, 1.6059043836821614599e-10); sp = fma(sp, r2, -2.5052108385441718775e-8); sp = fma(sp, r2, 2.7557319223985890653e-6);
    sp = fma(sp, r2, -1.9841269841269841270e-4); sp = fma(sp, r2, 8.3333333333333333333e-3); sp = fma(sp, r2, -1.6666666666666666667e-1); sp = fma(sp * r2, r, r);
    double cp = 4.7794773323873852974e-14; cp = fma(cp, r2, -1.1470745597729724714e-11); cp = fma(cp, r2, 2.0876756987868098979e-9); cp = fma(cp, r2, -2.7557319223985890653e-7);
    cp = fma(cp, r2, 2.4801587301587301587e-5); cp = fma(cp, r2, -1.3888888888888888889e-3); cp = fma(cp, r2, 4.1666666666666666667e-2); cp = fma(cp, r2, -0.5); cp = fma(cp, r2, 1.0);
    const int k = ((int)(long long)q) & 3;
    const double ss = (k & 1) ? cp : sp, cc = (k & 1) ? sp : cp;
    s = (float)((k & 2) ? -ss : ss); c = (float)(((k + 1) & 2) ? -cc : cc);
}
__device__ __forceinline__ void s5_build(const Params& p, int g, LAS unsigned char* lds, const int tid) {
    LAS float* apr = (LAS float*)lds;
    LAS float* api = apr + 17 * 64;
    LAS float* bbr = api + 17 * 64;
    LAS float* bbi = bbr + 1024;
    LAS float* cr = bbi + 1024;
    LAS float* ci = cr + 1024;
    LAS float* cfr = ci + 1024;
    LAS float* cfi = cfr + 64;
    LAS float* ktab = cfi + 64;
    const float dt = expf(p.log_dt[g]);
    for (int idx = tid; idx < 17 * 64; idx += 512) {
        const int tau = idx >> 6, pp = idx & 63; const float lr = p.lam_re[g * 64 + pp], li = p.lam_im[g * 64 + pp];
        const float mag = expf(lr * dt * (float)tau); float s, c; sincos_d((double)li * (double)dt * (double)tau, s, c);
        apr[idx] = mag * c; api[idx] = mag * s;
    }
    for (int idx = tid; idx < 1024; idx += 512) { cr[idx] = p.c_re[g * 1024 + idx]; ci[idx] = p.c_im[g * 1024 + idx]; }
    __syncthreads();
    if (tid < 64) {
        const float lr = p.lam_re[g * 64 + tid], li = p.lam_im[g * 64 + tid]; const float ar = apr[64 + tid], ai = api[64 + tid];
        const float den = lr * lr + li * li, nr = ar - 1.f;
        cfr[tid] = (nr * lr + ai * li) / den; cfi[tid] = (ai * lr - nr * li) / den;
        float* a16 = (float*)(p.ws + SM_A16) + (g * 64 + tid) * 2; a16[0] = apr[16 * 64 + tid]; a16[1] = api[16 * 64 + tid];
    }
    __syncthreads();
    for (int idx = tid; idx < 1024; idx += 512) { const int pp = idx >> 4; const float br = p.b_re[g * 1024 + idx], bi = p.b_im[g * 1024 + idx];
        bbr[idx] = cfr[pp] * br - cfi[pp] * bi; bbi[idx] = cfr[pp] * bi + cfi[pp] * br; }
    __syncthreads();
    for (int idx = tid; idx < 4096; idx += 512) {
        const int tau = idx >> 8, h = (idx >> 4) & 15, h2 = idx & 15; float s = 0.f;
        for (int pp = 0; pp < 64; ++pp) { const float zr = cr[h * 64 + pp] * apr[tau * 64 + pp] - ci[h * 64 + pp] * api[tau * 64 + pp], zi = cr[h * 64 + pp] * api[tau * 64 + pp] + ci[h * 64 + pp] * apr[tau * 64 + pp];
            s += zr * bbr[pp * 16 + h2] - zi * bbi[pp * 16 + h2]; }
        ktab[idx] = s;
    }
    __syncthreads();
    unsigned* KE = (unsigned*)(p.ws + W_KE) + (size_t)g * 256 * 192;
    for (int q = tid; q < 256 * 192; q += 512) {
        const int row = q / 192, col = (q - row * 192) * 2, t = row >> 4, h = row & 15; float v0, v1;
        if (col < 256) { const int s = col >> 4, h2 = col & 15; if (s <= t) { v0 = ktab[((t - s) * 16 + h) * 16 + h2]; v1 = ktab[((t - s) * 16 + h) * 16 + h2 + 1]; } else { v0 = 0.f; v1 = 0.f; } }
        else { const int j = col - 256; float e[2];
#pragma unroll
            for (int i = 0; i < 2; ++i) { const int jj = (j + i) & 63; const float crr = cr[h * 64 + jj], cii = ci[h * 64 + jj], ar = apr[(t + 1) * 64 + jj], ai = api[(t + 1) * 64 + jj];
                e[i] = (j + i < 64) ? (crr * ar - cii * ai) : -(crr * ai + cii * ar); }
            v0 = e[0]; v1 = e[1]; }
        KE[q] = cvt_pk_bf16(v0, v1);
    }
    unsigned* W5 = (unsigned*)(p.ws + W_W5) + (size_t)g * 256 * 128;
    for (int q = tid; q < 256 * 128; q += 512) {
        const int j = q >> 7, col = (q & 127) * 2, s = col >> 4, h2 = col & 15; float v[2] = {0.f, 0.f};
        if (j < 128) { const int jj = j & 63; const float ar = apr[(15 - s) * 64 + jj], ai = api[(15 - s) * 64 + jj];
#pragma unroll
            for (int i = 0; i < 2; ++i) { const float br = bbr[jj * 16 + h2 + i], bi = bbi[jj * 16 + h2 + i]; v[i] = (j < 64) ? (ar * br - ai * bi) : (ar * bi + ai * br); } }
        W5[q] = cvt_pk_bf16(v[0], v[1]);
    }
    __syncthreads();
}
__device__ __forceinline__ int win_src_col(int n) {
    if (n < 1024 || n >= 3072) return n;
    const int r = n - 1024, hh = r >> 8, rr = r & 255; return rr < 128 ? 1024 + hh * 128 + rr : 2048 + hh * 128 + (rr - 128);
}
__device__ __forceinline__ int wup_src_col(int n) { const int pn = n >> 8, rr = n & 255; return rr < 128 ? pn * 128 + rr : DFF + pn * 128 + (rr - 128); }

__device__ __forceinline__ void phase_prep(const Params& p, LAS unsigned char* lds, const int wv) {
    const int tid = wv * 64 + lane_id_v(), lane = tid & 63, wave = tid >> 6, G = gridDim.x;
    for (int g = blockIdx.x; g < 64; g += G) s5_build(p, g, lds, tid);
    LAS float* scr = (LAS float*)(lds + wave * 16384);
    const int gw = blockIdx.x * 8 + wave, NGW = G * 8;
    constexpr int I_IN = 16 * (NIN / 32), I_SQ = 16 * 32, I_UP = 16 * (NUP / 32), I_DN = (DFF / 64) * 32;
    constexpr int NIT = I_IN + 4 * I_SQ + I_UP + I_DN;
    unsigned char* ws = p.ws;
    for (int it = gw; it < NIT; it += NGW) {
        int r = it;
        if (r < I_IN) { const int nb = r % (NIN / 32), kb = r / (NIN / 32); transpose_item(p.w_in, NIN, 1024, (bf16_t*)(ws + W_WIN), nb * 32, win_src_col(nb * 32), kb * 64, p.mix_g, scr, lane); continue; } r -= I_IN;
        if (r < 4 * I_SQ) { const int w = r / I_SQ, rr = r % I_SQ, nb = rr % 32, kb = rr / 32;
            const float* src = w == 0 ? p.w_glu : w == 1 ? p.w_ssm : w == 2 ? p.w_hg : p.w_out; bf16_t* dst = (bf16_t*)(ws + (w == 0 ? W_GLU : w == 1 ? W_A : w == 2 ? W_B : W_O));
            transpose_item(src, 1024, 1024, dst, nb * 32, nb * 32, kb * 64, nullptr, scr, lane); continue; } r -= 4 * I_SQ;
        if (r < I_UP) { const int nb = r % (NUP / 32), kb = r / (NUP / 32); transpose_item(p.w_up, NUP, 1024, (bf16_t*)(ws + W_UP), nb * 32, wup_src_col(nb * 32), kb * 64, p.ffn_g, scr, lane); continue; } r -= I_UP;
        { const int nb = r % 32, kb = r / 32; transpose_item(p.w_down, 1024, DFF, (bf16_t*)(ws + W_DN), nb * 32, nb * 32, kb * 64, nullptr, scr, lane); }
    }
    bf16_t* xb = (bf16_t*)(ws + SLOT(2)); float* rs1 = (float*)(ws + SM_RS1);
    {
        f32x4 v[4], vn[4];
        int row = gw;
        if (row < M) { const int b = row / LTOK, t = row - b * LTOK; const float* hp = (t < NMETA) ? p.meta + (size_t)t * 1024 : p.x + ((size_t)b * SEQ + (t - NMETA)) * 1024;
#pragma unroll
            for (int j = 0; j < 4; ++j) v[j] = __builtin_nontemporal_load((const f32x4*)(hp + (lane + 64 * j) * 4)); }
        for (; row < M; row += NGW) {
            const int nrow = row + NGW;
            if (nrow < M) { const int b = nrow / LTOK, t = nrow - b * LTOK; const float* hp = (t < NMETA) ? p.meta + (size_t)t * 1024 : p.x + ((size_t)b * SEQ + (t - NMETA)) * 1024;
#pragma unroll
                for (int j = 0; j < 4; ++j) vn[j] = __builtin_nontemporal_load((const f32x4*)(hp + (lane + 64 * j) * 4)); }
            float s = 0.f;
#pragma unroll
            for (int j = 0; j < 4; ++j) s += (v[j][0] * v[j][0] + v[j][1] * v[j][1]) + (v[j][2] * v[j][2] + v[j][3] * v[j][3]);
            s = wave_sum(s);
            if (lane == 0) rs1[row] = __builtin_amdgcn_rsqf(s * (1.f / 1024.f) + EPS);
#pragma unroll
            for (int j = 0; j < 4; ++j) { u32x2 w; w.x = cvt_pk_bf16(v[j][0], v[j][1]); w.y = cvt_pk_bf16(v[j][2], v[j][3]); *(u32x2*)(xb + (size_t)row * 1024 + (lane + 64 * j) * 4) = w; }
#pragma unroll
            for (int j = 0; j < 4; ++j) v[j] = vn[j];
        }
    }
}

__device__ __forceinline__ f32x4 mfma_k16(const bf16x4 a, const bf16x4 b, const f32x4 c) {
    const bf16x4 z = (bf16x4){0, 0, 0, 0};
    return __builtin_amdgcn_mfma_f32_16x16x32_bf16(__builtin_shufflevector(a, z, 0, 1, 2, 3, 4, 5, 6, 7), __builtin_shufflevector(b, z, 0, 1, 2, 3, 4, 5, 6, 7), c, 0, 0, 0);
}
constexpr int HB_QI = 0, HB_KI = 4608, HB_KIT = 9216, HB_VT = 14336, HB_DEC = 19456, HB_SIZE = 20480;
constexpr int HB_O = 2 * HB_SIZE, HB_OSZ = 16 * 132 * 4;
__device__ __forceinline__ float row16_sum(float x) {
    x += dpp_f<0xB1>(x); x += dpp_f<0x4E>(x); x += dpp_f<0x141>(x); x += dpp_f<0x140>(x); return x;
}
__device__ __forceinline__ void phase_hgrn(const Params& p, LAS unsigned char* lds, const int wv) {
    const int lane = lane_id_v(), fr = lane & 15, fq = lane >> 4;
    const bf16_t* qi = (const bf16_t*)(p.ws + SLOT(3)); const bf16_t* ki = (const bf16_t*)(p.ws + SLOT(4)); const bf16_t* vb = (const bf16_t*)(p.ws + SLOT(5)); const bf16_t* ogb = (const bf16_t*)(p.ws + SLOT(6));
    const float* dec = (const float*)(p.ws + SM_DEC); bf16_t* yb = (bf16_t*)p.out;
    for (int bh = blockIdx.x; bh < BATCH * 8; bh += gridDim.x) {
        const int b = bh >> 3, hh = bh & 7;
        if (wv >= 4) {
            const int ptid = (wv - 4) * 64 + lane, t = ptid >> 4, c8 = (ptid & 15) * 8;
            const size_t goff0 = ((size_t)b * LTOK + t) * 1024 + hh * 128 + c8;
            const float* decp = dec + (size_t)(b * CPB) * 1024 + hh * 128 + (ptid & 127);
            const f32x4 ng0 = *(const f32x4*)(p.hg_norm + c8), ng1 = *(const f32x4*)(p.hg_norm + c8 + 4);
            u32x4 rq[3], rk[3], rv[3], ogr[3]; float rdec[3];
#pragma unroll
            for (int j = 0; j < 3; ++j) { const size_t go = goff0 + (size_t)j * 16384;
                rq[j] = *(const u32x4*)(qi + go); rk[j] = *(const u32x4*)(ki + go); rv[j] = *(const u32x4*)(vb + go); rdec[j] = (ptid < 128) ? decp[(size_t)j * 1024] : 0.f; }
            ogr[0] = *(const u32x4*)(ogb + goff0); ogr[1] = *(const u32x4*)(ogb + goff0 + 16384); ogr[2] = ogr[0];
#define HG_W(CH, SET) do { LAS unsigned char* buf_ = lds + ((CH) & 1) * HB_SIZE; \
                *(LAS u32x4*)(buf_ + HB_QI + t * 288 + c8 * 2) = rq[SET]; *(LAS u32x4*)(buf_ + HB_KI + t * 288 + c8 * 2) = rk[SET]; \
                LAS unsigned short* kt_ = (LAS unsigned short*)(buf_ + HB_KIT) + c8 * 20 + t; LAS unsigned short* vt_ = (LAS unsigned short*)(buf_ + HB_VT) + c8 * 20 + t; \
                const unsigned kw_[4] = {rk[SET].x, rk[SET].y, rk[SET].z, rk[SET].w}, vw_[4] = {rv[SET].x, rv[SET].y, rv[SET].z, rv[SET].w}; \
                _Pragma("unroll") for (int i_ = 0; i_ < 4; ++i_) { kt_[(2 * i_) * 20] = (unsigned short)(kw_[i_] & 0xffff); kt_[(2 * i_ + 1) * 20] = (unsigned short)(kw_[i_] >> 16); \
                    vt_[(2 * i_) * 20] = (unsigned short)(vw_[i_] & 0xffff); vt_[(2 * i_ + 1) * 20] = (unsigned short)(vw_[i_] >> 16); } \
                if (ptid < 128) ((LAS float*)(buf_ + HB_DEC))[ptid] = rdec[SET]; \
                if ((CH) + 3 < CPB) { const size_t go_ = goff0 + (size_t)((CH) + 3) * 16384; \
                    rq[SET] = *(const u32x4*)(qi + go_); rk[SET] = *(const u32x4*)(ki + go_); rv[SET] = *(const u32x4*)(vb + go_); if (ptid < 128) rdec[SET] = decp[(size_t)((CH) + 3) * 1024]; } } while (0)
#define HG_N(CH, SET) do { const LAS float* ob_ = (const LAS float*)(lds + HB_O + ((CH) & 1) * HB_OSZ) + t * 132 + c8; \
                const f32x4 o0_ = *(const LAS f32x4*)ob_, o1_ = *(const LAS f32x4*)(ob_ + 4); \
                float ss_ = ((o0_[0] * o0_[0] + o0_[1] * o0_[1]) + (o0_[2] * o0_[2] + o0_[3] * o0_[3])) + ((o1_[0] * o1_[0] + o1_[1] * o1_[1]) + (o1_[2] * o1_[2] + o1_[3] * o1_[3])); \
                ss_ = row16_sum(ss_); const float rs_ = __builtin_amdgcn_rsqf(ss_ * (1.f / 128.f) + EPS); \
                float g_[8]; unpack8(ogr[SET], g_); f32x4 r0_, r1_; \
                _Pragma("unroll") for (int i_ = 0; i_ < 4; ++i_) { r0_[i_] = o0_[i_] * rs_ * ng0[i_] * (g_[i_] * sigm(g_[i_])); r1_[i_] = o1_[i_] * rs_ * ng1[i_] * (g_[4 + i_] * sigm(g_[4 + i_])); } \
                *(u32x4*)(yb + goff0 + (size_t)(CH) * 16384) = pack8(r0_, r1_); } while (0)
            HG_W(0, 0);
            __syncthreads();
            for (int c0 = 0; c0 < CPB; c0 += 3) {
#pragma unroll
                for (int j = 0; j < 3; ++j) {
                    const int c = c0 + j;
                    if (c > 0) HG_N(c - 1, (j + 2) % 3);
                    if (c + 2 < CPB) ogr[(j + 2) % 3] = *(const u32x4*)(ogb + goff0 + (size_t)(c + 2) * 16384);
                    if (c + 1 < CPB) HG_W(c + 1, (j + 1) % 3);
                    __syncthreads();
                }
            }
            HG_N(CPB - 1, (CPB - 1) % 3);
#undef HG_W
#undef HG_N
        } else {
            __builtin_amdgcn_s_setprio(3);
            const int w = wv;
            f32x4 S[8][2];
#pragma unroll
            for (int i = 0; i < 8; ++i) { S[i][0] = (f32x4){0.f, 0.f, 0.f, 0.f}; S[i][1] = S[i][0]; }
            __syncthreads();
            for (int c = 0; c < CPB; ++c) {
                const LAS unsigned char* buf = lds + (c & 1) * HB_SIZE;
                bf16x8 qf[4], kf[4];
#pragma unroll
                for (int kk = 0; kk < 4; ++kk) {
                    const LAS unsigned char* qp = buf + HB_QI + fr * 288 + (32 * kk + 4 * fq) * 2; const LAS unsigned char* kp = buf + HB_KI + fr * 288 + (32 * kk + 4 * fq) * 2;
                    const bf16x4 q0 = *(const LAS bf16x4*)qp, q1 = *(const LAS bf16x4*)(qp + 32), k0 = *(const LAS bf16x4*)kp, k1 = *(const LAS bf16x4*)(kp + 32);
                    qf[kk] = __builtin_shufflevector(q0, q1, 0, 1, 2, 3, 4, 5, 6, 7); kf[kk] = __builtin_shufflevector(k0, k1, 0, 1, 2, 3, 4, 5, 6, 7);
                }
                f32x4 sT = (f32x4){0.f, 0.f, 0.f, 0.f};
#pragma unroll
                for (int kk = 0; kk < 4; ++kk) sT = __builtin_amdgcn_mfma_f32_16x16x32_bf16(kf[kk], qf[kk], sT, 0, 0, 0);
#pragma unroll
                for (int j = 0; j < 4; ++j) sT[j] = (4 * fq + j <= fr) ? sT[j] : 0.f;
                bf16x4 P; { const unsigned a = cvt_pk_bf16(sT[0], sT[1]), bq = cvt_pk_bf16(sT[2], sT[3]); P[0] = (short)(a & 0xffff); P[1] = (short)(a >> 16); P[2] = (short)(bq & 0xffff); P[3] = (short)(bq >> 16); }
                bf16x4 vf[2]; f32x4 o[2];
#pragma unroll
                for (int nt = 0; nt < 2; ++nt) { vf[nt] = *(const LAS bf16x4*)(buf + HB_VT + (32 * w + 16 * nt + fr) * 40 + fq * 8); o[nt] = mfma_k16(P, vf[nt], (f32x4){0.f, 0.f, 0.f, 0.f}); }
#pragma unroll
                for (int kk = 0; kk < 4; ++kk)
#pragma unroll
                    for (int nt = 0; nt < 2; ++nt) {
                        const u32x4 sw = pack8(S[2 * kk][nt], S[2 * kk + 1][nt]);
                        bf16x8 bs; bs[0] = (short)(sw.x & 0xffff); bs[1] = (short)(sw.x >> 16); bs[2] = (short)(sw.y & 0xffff); bs[3] = (short)(sw.y >> 16);
                        bs[4] = (short)(sw.z & 0xffff); bs[5] = (short)(sw.z >> 16); bs[6] = (short)(sw.w & 0xffff); bs[7] = (short)(sw.w >> 16);
                        o[nt] = __builtin_amdgcn_mfma_f32_16x16x32_bf16(qf[kk], bs, o[nt], 0, 0, 0);
                    }
#pragma unroll
                for (int T = 0; T < 8; ++T) {
                    const bf16x4 kT = *(const LAS bf16x4*)(buf + HB_KIT + (16 * T + fr) * 40 + fq * 8);
                    const f32x4 dv = *(const LAS f32x4*)(buf + HB_DEC + (16 * T + 4 * fq) * 4);
#pragma unroll
                    for (int nt = 0; nt < 2; ++nt) { S[T][nt] = mfma_k16(kT, vf[nt], S[T][nt]); S[T][nt] *= dv; }
                }
                LAS float* ob = (LAS float*)(lds + HB_O + (c & 1) * HB_OSZ);
#pragma unroll
                for (int nt = 0; nt < 2; ++nt)
#pragma unroll
                    for (int j = 0; j < 4; ++j) ob[(4 * fq + j) * 132 + 32 * w + 16 * nt + fr] = o[nt][j];
                __syncthreads();
            }
            __builtin_amdgcn_s_setprio(0);
        }
        __syncthreads();
    }
}

__device__ __forceinline__ void phase_scan(const Params& p, const int wv) {
    const int tid = wv * 64 + lane_id_v();
    {
        const bf16_t* xs = (const bf16_t*)(p.ws + SLOT(0)); const bf16_t* KE = (const bf16_t*)(p.ws + W_KE); bf16_t* y = (bf16_t*)(p.ws + SLOT(4));
        for (int gid = blockIdx.x * 512 + tid; gid < 64 * 256; gid += gridDim.x * 512) {
            const int g = gid >> 8, th = gid & 255, t = th >> 4, h = th & 15;
            const u32x4* kr = (const u32x4*)(KE + ((size_t)g * 256 + th) * 384); const u32x4* ur = (const u32x4*)(xs + (size_t)g * NCH * XS_LD);
            float a = 0.f;
#pragma unroll 4
            for (int k8 = 0; k8 < 32; ++k8) { float kv[8], uv[8]; unpack8(kr[k8], kv); unpack8(ur[k8], uv);
#pragma unroll
                for (int i = 0; i < 8; ++i) a += kv[i] * uv[i]; }
            const float u0 = __uint_as_float((unsigned)xs[(size_t)g * NCH * XS_LD + th] << 16);
            const bf16_t yv = (bf16_t)(cvt_pk_bf16(gelu_tanh(a + p.ssm_d[g * 16 + h] * u0), 0.f) & 0xffff);
            for (int b = 0; b < BATCH; ++b) y[((size_t)b * LTOK + t) * 1024 + g * 16 + h] = yv;
        }
    }
    const bf16_t* L = (const bf16_t*)p.out + UB / 2; bf16_t* xs5 = (bf16_t*)(p.ws + SLOT(0)); const float* a16 = (const float*)(p.ws + SM_A16);
    for (int gid = blockIdx.x * 512 + tid; gid < BATCH * 64 * 64; gid += gridDim.x * 512) {
        const int pp = gid & 63, g = (gid >> 6) & 63, b = gid >> 12;
        const float ar = a16[(g * 64 + pp) * 2], ai = a16[(g * 64 + pp) * 2 + 1];
        float sr = 0.f, si = 0.f;
        const bf16_t* lp = L + ((size_t)g * NCH + (size_t)b * CPB) * 128 + pp; bf16_t* xp = xs5 + ((size_t)g * NCH + (size_t)b * CPB) * XS_LD + 256 + pp;
#pragma unroll 43
        for (int c = 0; c < CPB; ++c) {
            const float lr = (c < CPB - 1) ? __uint_as_float((unsigned)lp[(size_t)c * 128] << 16) : 0.f, li = (c < CPB - 1) ? __uint_as_float((unsigned)lp[(size_t)c * 128 + 64] << 16) : 0.f;
            xp[(size_t)c * XS_LD] = (bf16_t)(cvt_pk_bf16(sr, 0.f) & 0xffff); xp[(size_t)c * XS_LD + 64] = (bf16_t)(cvt_pk_bf16(si, 0.f) & 0xffff);
            const float nr = ar * sr - ai * si + lr, ni = ar * si + ai * sr + li; sr = nr; si = ni;
        }
    }
}

__device__ __forceinline__ void phase_final(const Params& p, const int wv, const int r_begin, const int r_end, const int blk, const int nblk) {
    const bf16_t* h3 = (const bf16_t*)(p.ws + SLOT(0)); const float* ssq = (const float*)(p.ws + SM_SSQ3);
    const int lane = lane_id_v(), gw = blk * 8 + wv, NGW = nblk * 8;
    f32x4 gv[4];
#pragma unroll
    for (int j = 0; j < 4; ++j) gv[j] = *(const f32x4*)(p.fin_g + (lane + 64 * j) * 4);
    {
        u32x2 v[4], vn[4]; f32x4 sq[4], sqn[4];
        int r = r_begin + gw;
        if (r < r_end) { const int b = r / SEQ, t = r - b * SEQ; const size_t row = (size_t)b * LTOK + NMETA + t;
#pragma unroll
            for (int j = 0; j < 4; ++j) { v[j] = __builtin_nontemporal_load((const u32x2*)(h3 + row * 1024 + (lane + 64 * j) * 4)); sq[j] = *(const f32x4*)(ssq + row * 16 + j * 4); } }
        for (; r < r_end; r += NGW) {
            const int nr = r + NGW;
            if (nr < r_end) { const int b = nr / SEQ, t = nr - b * SEQ; const size_t row = (size_t)b * LTOK + NMETA + t;
#pragma unroll
                for (int j = 0; j < 4; ++j) { vn[j] = __builtin_nontemporal_load((const u32x2*)(h3 + row * 1024 + (lane + 64 * j) * 4)); sqn[j] = *(const f32x4*)(ssq + row * 16 + j * 4); } }
            const f32x4 s4 = (sq[0] + sq[1]) + (sq[2] + sq[3]);
            const float rs = __builtin_amdgcn_rsqf(((s4[0] + s4[1]) + (s4[2] + s4[3])) * (1.f / 1024.f) + EPS);
#pragma unroll
            for (int j = 0; j < 4; ++j) { const f32x4 hv = (f32x4){bf_lo(v[j].x), bf_hi(v[j].x), bf_lo(v[j].y), bf_hi(v[j].y)}; __builtin_nontemporal_store(hv * rs * gv[j], (f32x4*)(p.out + (size_t)r * 1024 + (lane + 64 * j) * 4)); }
#pragma unroll
            for (int j = 0; j < 4; ++j) { v[j] = vn[j]; sq[j] = sqn[j]; }
        }
    }
}

__device__ __forceinline__ void grid_bar(unsigned* ctr, unsigned target, const int wv) {
    asm volatile("s_waitcnt vmcnt(0)" ::: "memory");
    __syncthreads();
    if (wv == 0) {
        __builtin_amdgcn_fence(__ATOMIC_RELEASE, "agent");
        if (lane_id_v() == 0) {
            __hip_atomic_fetch_add(ctr, 1u, __ATOMIC_RELAXED, __HIP_MEMORY_SCOPE_AGENT);
            while (__hip_atomic_load(ctr, __ATOMIC_RELAXED, __HIP_MEMORY_SCOPE_AGENT) < target) __builtin_amdgcn_s_sleep(1);
        }
        __builtin_amdgcn_fence(__ATOMIC_ACQUIRE, "agent");
    }
    __syncthreads();
}
constexpr int LDS_HALO = pg8::STAGE_BYTES, LDS_BYTES = pg8::STAGE_BYTES + 8192;
constexpr int N_PHASES = 15;
__global__ void __launch_bounds__(512, 2) mk_fwd(Params p) {
    extern __shared__ __attribute__((aligned(16))) unsigned char lds_raw[];
    LAS unsigned char* lds = (LAS unsigned char*)lds_raw;
    unsigned char* ws = p.ws;
    const int G = gridDim.x, c = blockIdx.x, lo = p.ph_lo, hi = p.ph_hi;
    const int wv = __builtin_amdgcn_readfirstlane((int)(threadIdx.x >> 6));
    unsigned* bar_ctr = (unsigned*)(ws + CTL_OFF); unsigned nbar = 0;
#ifndef ONLY_PHASE
#define ONLY_PHASE -1
#endif
#define IN(k) ((ONLY_PHASE < 0 || ONLY_PHASE == (k)) && lo <= (k) && (k) < hi)
#if MK_PER_PHASE
#define SEAM(k) do { } while (0)
#else
#define SEAM(k) do { if (IN(k) && IN((k) + 1)) { ++nbar; grid_bar(bar_ctr, nbar * (unsigned)G, wv); } } while (0)
#endif
    bf16_t* xs5 = (bf16_t*)(ws + SLOT(0)); bf16_t* xb = (bf16_t*)(ws + SLOT(2));
    const float* rs1 = (const float*)(ws + SM_RS1);
    if (lo + 1 < hi) cg::this_grid().sync();
    if (IN(0)) { phase_prep(p, lds, wv); } SEAM(0);
    if (IN(1)) {
        pg8::Gemm g{xb, (const bf16_t*)(ws + W_WIN), 1024, 1024, 1024}; pg8::TileOrder S; S.init(M / 256, NG1A / 256, G, c, 1024, 1024);
        EpiG1a E{xs5, (bf16_t*)(ws + SLOT(3)), (bf16_t*)(ws + SLOT(4)), (bf16_t*)(ws + SLOT(5)), (bf16_t*)(ws + SLOT(6)), (float*)(ws + SM_DEC), rs1, p.lb_logits};
        pg8::gemm_phase(lds, g, S, E, wv);
    } SEAM(1);
    if (IN(2)) { phase_hgrn(p, lds, wv); }
    if (IN(3)) {
        pg8::Gemm g{xs5, (const bf16_t*)(ws + W_W5), 256, XS_LD, 256, CPB}; pg8::GroupOrder S; S.init(G, c, 256, 0);
        EpiS5i E{(bf16_t*)p.out + UB / 2};
        pg8::gemm_phase(lds, g, S, E, wv);
    } SEAM(3);
    if (IN(4)) { phase_scan(p, wv); } SEAM(4);
    if (IN(5)) {
        pg8::Gemm g{xs5, (const bf16_t*)(ws + W_KE), 384, XS_LD, 384, CPB}; pg8::GroupOrder S; S.init(G, c, 384, 1);
        EpiS5y E{xs5, p.ssm_d, (bf16_t*)(ws + SLOT(4))};
        pg8::gemm_phase(lds, g, S, E, wv);
    } SEAM(5);
    if (IN(6)) {
        pg8::Gemm g{(const bf16_t*)(ws + SLOT(4)), (const bf16_t*)(ws + W_GLU), 1024, 1024, 1024}; pg8::TileOrder S; S.init(M / 256, 12, G, c, 1024, 1024);
        S.split_pn = 4; S.a2_off = (long)SLOT(2) - (long)SLOT(4); S.b2_off = (long)(W_WIN + (size_t)NG1A * 2048) - (long)W_GLU;
        EpiGluGates E{EpiRow<0>{(const bf16_t*)(ws + SLOT(4)), (bf16_t*)(ws + SLOT(5)), nullptr}, EpiRow<1>{nullptr, (bf16_t*)(ws + SLOT(0)), rs1}};
        pg8::gemm_phase(lds, g, S, E, wv);
    } SEAM(6);
    if (IN(8)) {
        pg8::Gemm g{(const bf16_t*)(ws + SLOT(5)), (const bf16_t*)(ws + W_A), 1024, 1024, 1024}; pg8::TileOrder S; S.init(M / 256, 4, G, c, 1024, 1024);
        EpiRow<2> E{(const bf16_t*)(ws + SLOT(0)), (bf16_t*)(ws + SLOT(2)), nullptr};
        pg8::gemm_phase(lds, g, S, E, wv);
    } SEAM(8);
    if (IN(9)) {
        pg8::Gemm g{(const bf16_t*)p.out, (const bf16_t*)(ws + W_B), 1024, 1024, 1024}; pg8::TileOrder S; S.init(M / 256, 4, G, c, 1024, 1024);
        EpiRow<3> E{(const bf16_t*)(ws + SLOT(1)), (bf16_t*)(ws + SLOT(2)), nullptr};
        pg8::gemm_phase(lds, g, S, E, wv);
    } SEAM(9);
    if (IN(10)) {
        pg8::Gemm g{(const bf16_t*)(ws + SLOT(2)), (const bf16_t*)(ws + W_O), 1024, 1024, 1024}; pg8::TileOrder S; S.init(M / 256, 4, G, c, 1024, 1024);
        EpiOut E{p.x, p.meta, (bf16_t*)(ws + SLOT(3)), (float*)(ws + SM_SSQ2)};
        pg8::gemm_phase(lds, g, S, E, wv);
    } SEAM(10);
    if (IN(11)) {
        pg8::Gemm g{(const bf16_t*)(ws + SLOT(3)), (const bf16_t*)(ws + W_UP), 1024, 1024, 1024}; pg8::TileOrder S; S.init(UP_MT, DFF / 128, G, c, 1024, 1024, UP_STRIDE, -2);
        EpiUp E{(const float*)(ws + SM_SSQ2), p.conv_w, p.conv_b, (bf16_t*)(ws + SLOT(4)), (LAS float*)(lds + LDS_HALO)};
        pg8::gemm_phase(lds, g, S, E, wv);
    } SEAM(11);
    constexpr int R_TAIL = (BATCH - 1) * SEQ + (256 * 256 - (BATCH - 1) * LTOK - NMETA);
    if (IN(12)) {
        pg8::Gemm g{(const bf16_t*)(ws + SLOT(4)), (const bf16_t*)(ws + W_DN), DFF, DFF, DFF}; pg8::TileOrder S; S.init(256, 4, G, c, DFF, DFF);
        EpiDown E{(const bf16_t*)(ws + SLOT(3)), (bf16_t*)(ws + SLOT(0)), (float*)(ws + SM_SSQ3), 0};
        pg8::gemm_phase(lds, g, S, E, wv);
    } SEAM(12);
    if (IN(13)) {
        if (G > 16 && c < 8) {
            pg8::Gemm g{(const bf16_t*)(ws + SLOT(4)), (const bf16_t*)(ws + W_DN), DFF, DFF, DFF}; pg8::TileOrder S; S.init(2, 4, 8, c, DFF, DFF, 256, 65536);
            EpiDown E{(const bf16_t*)(ws + SLOT(3)), (bf16_t*)(ws + SLOT(0)), (float*)(ws + SM_SSQ3), 256};
            pg8::gemm_phase(lds, g, S, E, wv);
        } else if (G > 16) { phase_final(p, wv, 0, R_TAIL, c - 8, G - 8); }
        else {
            pg8::Gemm g{(const bf16_t*)(ws + SLOT(4)), (const bf16_t*)(ws + W_DN), DFF, DFF, DFF}; pg8::TileOrder S; S.init(2, 4, G, c, DFF, DFF, 256, 65536);
            EpiDown E{(const bf16_t*)(ws + SLOT(3)), (bf16_t*)(ws + SLOT(0)), (float*)(ws + SM_SSQ3), 256};
            pg8::gemm_phase(lds, g, S, E, wv);
        }
    } SEAM(13);
    if (IN(14)) { if (G > 16) phase_final(p, wv, R_TAIL, BATCH * SEQ, c, G); else phase_final(p, wv, 0, BATCH * SEQ, c, G); }
}

#ifndef DBG_STOP
#define DBG_STOP -1
#endif
#ifndef DBG_SLOT
#define DBG_SLOT 100
#endif
__global__ void dbg_copy_bf16(const bf16_t* src, float* out, size_t n) { for (size_t i = (size_t)blockIdx.x * blockDim.x + threadIdx.x; i < n; i += (size_t)gridDim.x * blockDim.x) out[i] = __uint_as_float((unsigned)src[i] << 16); }
__global__ void dbg_sum4(const bf16_t* a, const bf16_t* b, const bf16_t* c, const float* d, float* out, size_t n) { for (size_t i = (size_t)blockIdx.x * blockDim.x + threadIdx.x; i < n; i += (size_t)gridDim.x * blockDim.x) out[i] = __uint_as_float((unsigned)a[i] << 16) + __uint_as_float((unsigned)b[i] << 16) + __uint_as_float((unsigned)c[i] << 16) + d[i % ((size_t)NCH * 1024)]; }
__global__ void dbg_copy_f32(const float* src, float* out, size_t n) { for (size_t i = (size_t)blockIdx.x * blockDim.x + threadIdx.x; i < n; i += (size_t)gridDim.x * blockDim.x) out[i] = src[i]; }
extern "C" void kernel_launch(void* const* d_in, const int* in_sizes, int n_in, void* d_out, int out_size, void* d_ws, size_t ws_size, hipStream_t stream) {
    static int grid = 0;
    if (grid == 0) {
        if (n_in != 24 || ws_size < WS_NEED || out_size != BATCH * SEQ * D) { fprintf(stderr, "kernel_launch: unexpected shapes (n_in %d, ws %zu need %zu, out %d)\n", n_in, ws_size, (size_t)WS_NEED, out_size); grid = -1; return; }
        int dev = 0, cus = 0, per_cu = 0;
        (void)hipGetDevice(&dev); (void)hipDeviceGetAttribute(&cus, hipDeviceAttributeMultiprocessorCount, dev);
        if (hipFuncSetAttribute((const void*)mk_fwd, hipFuncAttributeMaxDynamicSharedMemorySize, LDS_BYTES) != hipSuccess) { fprintf(stderr, "kernel_launch: hipFuncSetAttribute failed\n"); grid = -1; return; }
        if (hipOccupancyMaxActiveBlocksPerMultiprocessor(&per_cu, (const void*)mk_fwd, 512, LDS_BYTES) != hipSuccess || per_cu < 1) { fprintf(stderr, "kernel_launch: occupancy query says %d\n", per_cu); per_cu = 1; }
        (void)hipGetLastError();
        grid = cus * 1;
    }
    if (grid < 0) return;
    Params p{};
    const float** pp = (const float**)&p;
    for (int i = 0; i < 24; ++i) pp[i] = (const float*)d_in[i];
    p.out = (float*)d_out; p.ws = (unsigned char*)d_ws;
#if MK_PER_PHASE
    for (int ph = 0; ph < N_PHASES; ++ph) { if (DBG_STOP >= 0 && ph > DBG_STOP) break; p.ph_lo = ph; p.ph_hi = ph + 1; hipLaunchKernelGGL(mk_fwd, dim3(grid), dim3(512), LDS_BYTES, stream, p); }
    if (DBG_STOP >= 0) {
        const size_t n = (size_t)BATCH * SEQ * D;
        if (DBG_SLOT == 100) { hipMemcpyAsync((char*)d_ws + SLOT(2), d_out, n * 2, hipMemcpyDeviceToDevice, stream); hipLaunchKernelGGL(dbg_copy_bf16, dim3(2048), dim3(256), 0, stream, (const bf16_t*)((char*)d_ws + SLOT(2)), (float*)d_out, n); }
        else if (DBG_SLOT == 150) hipLaunchKernelGGL(dbg_sum4, dim3(2048), dim3(256), 0, stream, (const bf16_t*)((char*)d_ws + SLOT(4)), (const bf16_t*)((char*)d_ws + SLOT(5)), (const bf16_t*)((char*)d_ws + SLOT(6)), (const float*)((char*)d_ws + SM_DEC), (float*)d_out, n);
        else if (DBG_SLOT >= 200) hipLaunchKernelGGL(dbg_copy_f32, dim3(2048), dim3(256), 0, stream, (const float*)((char*)d_ws + SLOT(DBG_SLOT - 200)), (float*)d_out, n);
        else hipLaunchKernelGGL(dbg_copy_bf16, dim3(2048), dim3(256), 0, stream, (const bf16_t*)((char*)d_ws + SLOT(DBG_SLOT)), (float*)d_out, n);
    }
#else
    p.ph_lo = 0; p.ph_hi = N_PHASES;
    (void)hipMemsetAsync((char*)d_ws + CTL_OFF, 0, 256, stream);
    void* args[] = {&p};
    hipError_t e = hipLaunchCooperativeKernel((const void*)mk_fwd, dim3(grid), dim3(512), args, LDS_BYTES, stream);
    if (e != hipSuccess) fprintf(stderr, "cooperative launch failed: %s (grid %d)\n", hipGetErrorString(e), grid);
#endif
}
```
